# Optimizing an MI355X kernel written in HIP

```python
import math
import jax
import jax.numpy as jnp
from jax import lax
import numpy as np

D_MODEL = 1024
BATCH = 8
SEQ = 4096
DEPTH = 1

CTX_LEN = 256
GRID_W = 64
N_HEADS = 8
HEAD_DIM = 64
D_ATTN = N_HEADS * 2 * HEAD_DIM
D_HYENA = D_MODEL
SHORT_CONV = 3
FILTER_EMB = 33
FILTER_ORDER = 64
DECAY_TARGET = 1e-2
FAST_DECAY_PCT = 0.3
SLOW_DECAY_PCT = 1.5
D_FF = 2816
ROPE_THETA = 10000.0
Q_BLOCK = 128
N_MOD = 9
N_PROJ = 3 * D_HYENA + 3 * D_ATTN + 2 * D_MODEL
SPLITS = (3 * D_HYENA, 3 * D_HYENA + D_ATTN, 3 * D_HYENA + 2 * D_ATTN, 3 * D_HYENA + 3 * D_ATTN)
EPS = 1e-6

kernel_name = 'hybrid_hyena_diffattn_macaron_dit_layer'


def rmsnorm(x, g):
    xf = x.astype(jnp.float32)
    y = xf * lax.rsqrt(jnp.mean(xf * xf, axis=-1, keepdims=True) + EPS)
    return (y * g.astype(jnp.float32)).astype(x.dtype)


def modulate(x, shift, scale):
    return x * (1.0 + scale) + shift


def swiglu(x, w_in, w_out):
    gate, up = jnp.split(x @ w_in, 2, axis=-1)
    return (jax.nn.silu(gate) * up) @ w_out


def ffn_half(s, shift, scale, gate, g_pre, g_post, w_in, w_out):
    h = swiglu(modulate(rmsnorm(s, g_pre), shift, scale), w_in, w_out)
    return s + 0.5 * gate * rmsnorm(h, g_post)


def short_conv(x, w, b):
    L = x.shape[1]
    pad = SHORT_CONV // 2
    xp = jnp.pad(x, ((0, 0), (pad, pad), (0, 0)))
    return sum(xp[:, j:j + L] * w[j] for j in range(SHORT_CONV)) + b


def hyena_kernel(L, w1, b1, w2, b2, w3, b3, w4, freq):
    f32 = jnp.float32
    bands = (FILTER_EMB - 1) // 2
    t = jnp.linspace(0.0, 1.0, L, dtype=f32)[:, None]
    w = 2.0 * math.pi * jnp.arange(L, dtype=f32)[:, None] / L
    f = jnp.linspace(1e-4, bands - 1, bands, dtype=f32)[None, :]
    z = jnp.concatenate([t, jnp.cos(f * w), -jnp.sin(f * w)], axis=-1)
    h = jnp.sin(freq * (z @ w1 + b1))
    h = jnp.sin(freq * (h @ w2 + b2))
    h = jnp.sin(freq * (h @ w3 + b3))
    h = (h @ w4).astype(f32)
    deltas = jnp.linspace(math.log(DECAY_TARGET) / SLOW_DECAY_PCT,
                          math.log(DECAY_TARGET) / FAST_DECAY_PCT, D_HYENA, dtype=f32)
    decay = jnp.exp(-t * jnp.abs(deltas))
    h_fwd, h_bwd = jnp.split(h, 2, axis=-1)
    h_fwd = h_fwd * decay
    h_bwd = h_bwd * decay
    k = jnp.concatenate([h_fwd, jnp.zeros_like(h_fwd[:1]), h_bwd[:0:-1]], axis=0)
    return k / (jnp.sum(jnp.abs(k), axis=0, keepdims=True) + EPS)


def bidir_long_conv(u, k):
    L = u.shape[1]
    uf = jnp.fft.rfft(u.astype(jnp.float32), n=2 * L, axis=1)
    kf = jnp.fft.rfft(k, n=2 * L, axis=0)
    y = jnp.fft.irfft(uf * kf[None], n=2 * L, axis=1)[:, :L]
    return y.astype(u.dtype)


def hyena_branch(z_hy, conv_w, conv_b, filt, hy_bias):
    z = short_conv(z_hy, conv_w, conv_b)
    x0, x1, v = jnp.split(z, 3, axis=-1)
    k = hyena_kernel(z.shape[1], *filt)
    u = v * x1
    y = bidir_long_conv(u, k) + u * hy_bias
    return y * x0


def axial_rope_tables(L):
    rows = L // GRID_W
    r, col = jnp.meshgrid(jnp.arange(rows), jnp.arange(GRID_W), indexing='ij')
    r = r.reshape(-1).astype(jnp.float32)
    col = col.reshape(-1).astype(jnp.float32)
    half = HEAD_DIM // 2
    inv = ROPE_THETA ** (-jnp.arange(0, half, 2, dtype=jnp.float32) / half)
    ang = jnp.stack([r[:, None] * inv, col[:, None] * inv], axis=1)
    return jnp.cos(ang), jnp.sin(ang)


def apply_axial_rope(x, cos, sin):
    B, L = x.shape[:2]
    xr = x.reshape(B, L, N_HEADS, 2, 2, 2, HEAD_DIM // 4)
    x0, x1 = xr[..., 0, :], xr[..., 1, :]
    c = cos[None, :, None, None]
    s = sin[None, :, None, None]
    out = jnp.stack([x0 * c - x1 * s, x0 * s + x1 * c], axis=-2)
    return out.reshape(x.shape).astype(x.dtype)


def diff_attention(q, k, v, lam):
    B, L = q.shape[:2]
    nb = L // Q_BLOCK
    qb = jnp.moveaxis(q.reshape(B, nb, Q_BLOCK, N_HEADS, 2, HEAD_DIM), 1, 0)

    def block(qblk):
        s = jnp.einsum('bqhmd,bkhmd->bhmqk', qblk, k).astype(jnp.float32) * (HEAD_DIM ** -0.5)
        p = jax.nn.softmax(s, axis=-1)
        p = p[:, :, 0] - lam * p[:, :, 1]
        return jnp.einsum('bhqk,bkhe->bqhe', p.astype(v.dtype), v)

    o = lax.map(block, qb)
    return jnp.moveaxis(o, 0, 1).reshape(B, L, N_HEADS, 2 * HEAD_DIM)


def context_kv(h, w_in):
    B, L = h.shape[:2]
    k, v = jnp.split(h @ w_in[:, SPLITS[1]:SPLITS[3]], 2, axis=-1)
    return k.reshape(B, L, N_HEADS, 2, HEAD_DIM), v.reshape(B, L, N_HEADS, 2 * HEAD_DIM)


def token_mixer(h, w_in, conv_w, conv_b, filt, hy_bias, lam, lam_init, subln_g,
                w_hy_out, w_da_out, w_o, rope, ctx_kv):
    B, L = h.shape[:2]
    z_hy, q, k, v, gates = jnp.split(h @ w_in, SPLITS, axis=-1)
    y_hy = hyena_branch(z_hy, conv_w, conv_b, filt, hy_bias) @ w_hy_out
    q = q.reshape(B, L, N_HEADS, 2, HEAD_DIM)
    k = k.reshape(B, L, N_HEADS, 2, HEAD_DIM)
    v = v.reshape(B, L, N_HEADS, 2 * HEAD_DIM)
    if rope is not None:
        q = apply_axial_rope(q, *rope)
        k = apply_axial_rope(k, *rope)
    if ctx_kv is not None:
        k = jnp.concatenate([k, ctx_kv[0]], axis=1)
        v = jnp.concatenate([v, ctx_kv[1]], axis=1)
    o = diff_attention(q, k, v, lam)
    o = rmsnorm(o, subln_g) * (1.0 - lam_init)
    y_da = o.reshape(B, L, D_ATTN) @ w_da_out
    g_hy, g_da = jnp.split(jax.nn.sigmoid(gates), 2, axis=-1)
    return (g_hy * y_hy + g_da * y_da) @ w_o


def setup_inputs(seed: int = 0) -> dict:
    key = jax.random.key(seed)
    ks = jax.random.split(key, 32)
    f32 = jnp.float32

    def nrm(k, shape, scale):
        return jax.random.normal(k, shape, f32) * scale

    return {
        'x': nrm(ks[0], (BATCH, SEQ, D_MODEL), 1.0),
        'c': nrm(ks[1], (BATCH, D_MODEL), 1.0),
        'ctx': nrm(ks[2], (BATCH, CTX_LEN, D_MODEL), 1.0),
        'c_ctx': nrm(ks[3], (D_MODEL,), 1.0),
        'w_ada': nrm(ks[4], (DEPTH, D_MODEL, N_MOD * D_MODEL), 0.5 * D_MODEL ** -0.5),
        'b_ada': nrm(ks[5], (DEPTH, N_MOD * D_MODEL), 0.01),
        'norm_g': 1.0 + nrm(ks[6], (DEPTH, 6, D_MODEL), 0.02),
        'w_ff_in': nrm(ks[7], (DEPTH, 2, D_MODEL, 2 * D_FF), D_MODEL ** -0.5),
        'w_ff_out': nrm(ks[8], (DEPTH, 2, D_FF, D_MODEL), D_FF ** -0.5),
        'w_in': nrm(ks[9], (DEPTH, D_MODEL, N_PROJ), D_MODEL ** -0.5),
        'hy_conv_w': nrm(ks[10], (DEPTH, SHORT_CONV, 3 * D_HYENA), SHORT_CONV ** -0.5),
        'hy_conv_b': nrm(ks[11], (DEPTH, 3 * D_HYENA), 0.01),
        'filt_w1': nrm(ks[12], (DEPTH, FILTER_EMB, FILTER_ORDER), FILTER_EMB ** -0.5),
        'filt_b1': nrm(ks[13], (DEPTH, FILTER_ORDER), 0.1),
        'filt_w2': nrm(ks[14], (DEPTH, FILTER_ORDER, FILTER_ORDER), FILTER_ORDER ** -0.5),
        'filt_b2': nrm(ks[15], (DEPTH, FILTER_ORDER), 0.1),
        'filt_w3': nrm(ks[16], (DEPTH, FILTER_ORDER, FILTER_ORDER), FILTER_ORDER ** -0.5),
        'filt_b3': nrm(ks[17], (DEPTH, FILTER_ORDER), 0.1),
        'filt_w4': nrm(ks[18], (DEPTH, FILTER_ORDER, 2 * D_HYENA), FILTER_ORDER ** -0.5),
        'filt_freq': 1.0 + nrm(ks[19], (DEPTH, FILTER_ORDER), 0.01),
        'hy_bias': nrm(ks[20], (DEPTH, D_HYENA), 0.1),
        'lambda_q1': nrm(ks[21], (DEPTH, HEAD_DIM), 0.1),
        'lambda_k1': nrm(ks[22], (DEPTH, HEAD_DIM), 0.1),
        'lambda_q2': nrm(ks[23], (DEPTH, HEAD_DIM), 0.1),
        'lambda_k2': nrm(ks[24], (DEPTH, HEAD_DIM), 0.1),
        'subln_g': 1.0 + nrm(ks[25], (DEPTH, 2 * HEAD_DIM), 0.02),
        'w_hy_out': nrm(ks[26], (DEPTH, D_HYENA, D_MODEL), D_HYENA ** -0.5),
        'w_da_out': nrm(ks[27], (DEPTH, D_ATTN, D_MODEL), D_ATTN ** -0.5),
        'w_o': nrm(ks[28], (DEPTH, D_MODEL, D_MODEL), D_MODEL ** -0.5),
    }


def reference(x, c, ctx, c_ctx, w_ada, b_ada, norm_g, w_ff_in, w_ff_out, w_in,
              hy_conv_w, hy_conv_b, filt_w1, filt_b1, filt_w2, filt_b2, filt_w3, filt_b3,
              filt_w4, filt_freq, hy_bias, lambda_q1, lambda_k1, lambda_q2, lambda_k2,
              subln_g, w_hy_out, w_da_out, w_o):
    rope = axial_rope_tables(x.shape[1])
    xs, cs = x, ctx
    for l in range(DEPTH):
        lam_init = 0.8 - 0.6 * math.exp(-0.3 * l)
        lam = (jnp.exp(jnp.sum(lambda_q1[l] * lambda_k1[l]).astype(jnp.float32))
               - jnp.exp(jnp.sum(lambda_q2[l] * lambda_k2[l]).astype(jnp.float32)) + lam_init)
        mod_x = jnp.split((jax.nn.silu(c) @ w_ada[l] + b_ada[l])[:, None, :], N_MOD, axis=-1)
        mod_c = jnp.split((jax.nn.silu(c_ctx) @ w_ada[l] + b_ada[l])[None, None, :], N_MOD, axis=-1)
        g = norm_g[l]
        filt = (filt_w1[l], filt_b1[l], filt_w2[l], filt_b2[l], filt_w3[l], filt_b3[l],
                filt_w4[l], filt_freq[l])
        mixer_params = (w_in[l], hy_conv_w[l], hy_conv_b[l], filt, hy_bias[l], lam, lam_init,
                        subln_g[l], w_hy_out[l], w_da_out[l], w_o[l])
        xs = ffn_half(xs, mod_x[0], mod_x[1], mod_x[2], g[0], g[1], w_ff_in[l, 0], w_ff_out[l, 0])
        cs = ffn_half(cs, mod_c[0], mod_c[1], mod_c[2], g[0], g[1], w_ff_in[l, 0], w_ff_out[l, 0])
        hx = modulate(rmsnorm(xs, g[2]), mod_x[3], mod_x[4])
        hc = modulate(rmsnorm(cs, g[2]), mod_c[3], mod_c[4])
        y = token_mixer(hx, *mixer_params, rope, context_kv(hc, w_in[l]))
        xs = xs + mod_x[5] * rmsnorm(y, g[3])
        if l < DEPTH - 1:
            yc = token_mixer(hc, *mixer_params, None, None)
            cs = cs + mod_c[5] * rmsnorm(yc, g[3])
            cs = ffn_half(cs, mod_c[6], mod_c[7], mod_c[8], g[4], g[5], w_ff_in[l, 1], w_ff_out[l, 1])
        xs = ffn_half(xs, mod_x[6], mod_x[7], mod_x[8], g[4], g[5], w_ff_in[l, 1], w_ff_out[l, 1])
    return xs
```

```cpp
#include <hip/hip_runtime.h>
#include <cstdio>
namespace pg8 {
#define PG8_LAS __attribute__((address_space(3)))
typedef unsigned short bf16_t;
typedef short bf16x8 __attribute__((ext_vector_type(8)));
typedef float f32x4 __attribute__((ext_vector_type(4)));
typedef unsigned u32x4 __attribute__((ext_vector_type(4)));
constexpr int BM = 256, BK = 64, HALF = 128, HTB = HALF * BK * 2  , STAGE_BYTES = 8 * HTB, NXCD = 8, WGM = 8;

__host__ __device__ __forceinline__ int lds_byte(int r, int c) { const int st = (r >> 4) * 2 + (c >> 5), rr = r & 15, cc = c & 31, ob = rr * 64 + cc * 2; return st * 1024 + (ob ^ (((ob >> 9) & 1) << 5)); }
__host__ __device__ __forceinline__ void stage_rc(int b, int& R, int& C) { const int st = b / 1024, sb = b % 1024, swz = sb ^ (((sb >> 9) & 1) << 5); R = (st >> 1) * 16 + swz / 64; C = (st & 1) * 32 + (swz % 64) / 2; }
__host__ __device__ __forceinline__ int perm32(int rho) { const int n = rho >> 4, i = rho & 15; return 8 * (i >> 2) + 4 * n + (i & 3); }

struct Unit { int pm, pn; };
struct Gemm { const bf16_t* A; const bf16_t* Bt; int M, N, K; };

struct StaticOrder {
    int nM, nN, nwg, G, c;
    __host__ __device__ void init(int M, int N, int G_, int c_) { nM = M / BM; nN = N / BM; nwg = nM * nN; G = G_; c = c_; }
    __host__ __device__ bool next(int i, Unit& u) const {
        const long L = (long)i * G + c; if (L >= nwg) return false;
        int wgid = (int)L; { const int q = nwg / NXCD, r = nwg % NXCD, xcd = wgid % NXCD, off = wgid / NXCD; wgid = (xcd < r ? xcd * (q + 1) : r * (q + 1) + (xcd - r) * q) + off; }
        const int nig = WGM * nN, gid = wgid / nig, fm = gid * WGM, gsz = (nM - fm) < WGM ? (nM - fm) : WGM;
        u.pm = fm + ((wgid % nig) % gsz); u.pn = (wgid % nig) / gsz; return true;
    }
    __device__ __forceinline__ void a_ready(const Unit&) const {}
    __device__ __forceinline__ void done(const Unit&) const {}
};
__device__ __forceinline__ unsigned cvt_pk_bf16(float lo, float hi) { unsigned r; asm volatile("v_cvt_pk_bf16_f32 %0, %1, %2" : "=v"(r) : "v"(lo), "v"(hi)); return r; }
typedef float f32x2 __attribute__((ext_vector_type(2)));
template <class Epi, class Sched, bool STAMP = false>
__device__ __forceinline__ void gemm_phase(PG8_LAS unsigned char* lds, const Gemm g, const Sched& S, const Epi& E, unsigned long long* stamps) {
    int tid_ = threadIdx.x; asm volatile("" : "+v"(tid_)); const int tid = tid_, wid = __builtin_amdgcn_readfirstlane(tid >> 6), lane = tid & 63, wr = wid >> 2, wc = wid & 3, fr = lane & 15, fq = lane >> 4;
    const int K = g.K, nt = K / BK;
    int ts_lo = 0, ts_hi = 0, nts = 0; const unsigned long long rt_entry = STAMP ? (unsigned long long)wall_clock64() : 0ull;
#define PG8_STAMP() do { if (STAMP && wid == 0 && nts < 64) { const unsigned long long _c = (unsigned long long)clock64(); \
        ts_lo = (lane == nts) ? (int)(unsigned)_c : ts_lo; ts_hi = (lane == nts) ? (int)(unsigned)(_c >> 32) : ts_hi; ++nts; } } while (0)
    PG8_STAMP();
    unsigned voffA[2], voffB[2];
#pragma unroll
    for (int i = 0; i < 2; ++i) { int R, C; stage_rc(tid * 16 + i * 8192, R, C); const int Rb = Epi::PERM ? ((R & ~31) + perm32(R & 31)) : R;
        voffA[i] = (unsigned)(R * K + C) * 2u; voffB[i] = (unsigned)(Rb * K + C) * 2u; }
    const size_t kstep = (size_t)(BK * 2);
    const size_t hstep = (size_t)HALF * K * 2;
    const size_t tstep = 2 * hstep;
    const unsigned ldsw = (unsigned)wid * 1024u;
    const int aoff = lds_byte(wr * 64 + fr, fq * 8), boff = lds_byte(wc * 32 + fr, fq * 8);
#define PG8_SA(b, h) (((b) * 2 + (h)) * HTB)
#define PG8_SB(b, h) ((4 + (b) * 2 + (h)) * HTB)
#define PG8_STAGE(bufoff, gbase, voff) do { _Pragma("unroll") for (int _i = 0; _i < 2; ++_i) \
        __builtin_amdgcn_global_load_lds((const unsigned*)((const char*)(gbase) + (voff)[_i]), (PG8_LAS unsigned*)(lds + (bufoff) + ldsw + _i * 8192), 16, 0, 0); } while (0)
#define PG8_LDA(dst, b, h) do { _Pragma("unroll") for (int m = 0; m < 4; ++m) _Pragma("unroll") for (int k = 0; k < 2; ++k) dst[m][k] = *(const PG8_LAS bf16x8*)(lds + PG8_SA(b, h) + aoff + m * 2048 + k * 1024); } while (0)
#define PG8_LDB(dst, b, h) do { _Pragma("unroll") for (int n = 0; n < 2; ++n) _Pragma("unroll") for (int k = 0; k < 2; ++k) dst[n][k] = *(const PG8_LAS bf16x8*)(lds + PG8_SB(b, h) + boff + n * 2048 + k * 1024); } while (0)
#define PG8_MMA(ai, bj, At, Bt) do { __builtin_amdgcn_s_setprio(1); _Pragma("unroll") for (int m = 0; m < 4; ++m) _Pragma("unroll") for (int n = 0; n < 2; ++n) _Pragma("unroll") for (int k = 0; k < 2; ++k) \
        acc[ai][bj][m][n] = __builtin_amdgcn_mfma_f32_16x16x32_bf16(Bt[n][k], At[m][k], acc[ai][bj][m][n], 0, 0, 0); __builtin_amdgcn_s_setprio(0); } while (0)
#define PG8_WAIT_V(n) asm volatile("s_waitcnt vmcnt(" #n ")" ::: "memory")
#define PG8_WAIT_L(n) asm volatile("s_waitcnt lgkmcnt(" #n ")" ::: "memory")
#define PG8_BAR __builtin_amdgcn_s_barrier()
#define PG8_SCHED __builtin_amdgcn_sched_barrier(0)
    Unit cur, nxt; int ui = 0;
    if (!S.next(0, cur)) return;
    f32x4 acc[2][2][4][2];
#pragma unroll
    for (int a = 0; a < 2; ++a)
#pragma unroll
        for (int b = 0; b < 2; ++b)
#pragma unroll
            for (int m = 0; m < 4; ++m)
#pragma unroll
                for (int n = 0; n < 2; ++n) acc[a][b][m][n] = (f32x4){0.f, 0.f, 0.f, 0.f};
    bf16x8 At[4][2], B0[2][2], B1[2][2];
    const char* cA = (const char*)g.A + (size_t)cur.pm * tstep; const char* cB = (const char*)g.Bt + (size_t)cur.pn * tstep;
    S.a_ready(cur);
    PG8_STAGE(PG8_SB(0, 0), cB, voffB); PG8_STAGE(PG8_SA(0, 0), cA, voffA); PG8_STAGE(PG8_SB(0, 1), cB + hstep, voffB); PG8_STAGE(PG8_SA(0, 1), cA + hstep, voffA);
    if (wr == 1) PG8_BAR;
    PG8_WAIT_V(4); PG8_BAR;
    PG8_STAGE(PG8_SB(1, 0), cB + kstep, voffB); PG8_STAGE(PG8_SA(1, 0), cA + kstep, voffA); PG8_STAGE(PG8_SB(1, 1), cB + hstep + kstep, voffB);
    PG8_WAIT_V(6); PG8_BAR;
    PG8_STAMP();
    for (;;) {
        const bool has_next = S.next(ui + 1, nxt);
        const char* nA = has_next ? (const char*)g.A + (size_t)nxt.pm * tstep : cA; const char* nB = has_next ? (const char*)g.Bt + (size_t)nxt.pn * tstep : cB;
        for (int t = 0; t < nt; t += 2) {
            const bool last = (t == nt - 2);
            const char* a1 = cA + (size_t)(t + 1) * kstep;
            const char* a2 = last ? nA : cA + (size_t)(t + 2) * kstep; const char* b2 = last ? nB : cB + (size_t)(t + 2) * kstep;
            const char* a3 = a2 + kstep; const char* b3 = b2 + kstep;
            if (last && has_next) S.a_ready(nxt);
            PG8_LDB(B0, 0, 0); PG8_SCHED; PG8_LDA(At, 0, 0); PG8_STAGE(PG8_SA(1, 1), a1 + hstep, voffA);
            PG8_WAIT_L(8); PG8_BAR; PG8_WAIT_L(0); PG8_MMA(0, 0, At, B0); PG8_BAR; PG8_SCHED;
            PG8_LDB(B1, 0, 1); PG8_STAGE(PG8_SB(0, 0), b2, voffB);
            PG8_BAR; PG8_WAIT_L(0); PG8_MMA(0, 1, At, B1); PG8_BAR;
            PG8_LDA(At, 0, 1); PG8_STAGE(PG8_SA(0, 0), a2, voffA);
            PG8_BAR; PG8_WAIT_L(0); PG8_MMA(1, 0, At, B0); PG8_BAR; PG8_SCHED;
            PG8_STAGE(PG8_SB(0, 1), b2 + hstep, voffB);
            PG8_WAIT_V(6); PG8_BAR; PG8_MMA(1, 1, At, B1); PG8_BAR;
            PG8_LDB(B0, 1, 0); PG8_SCHED; PG8_LDA(At, 1, 0); PG8_STAGE(PG8_SA(0, 1), a2 + hstep, voffA);
            PG8_WAIT_L(8); PG8_BAR; PG8_WAIT_L(0); PG8_MMA(0, 0, At, B0); PG8_BAR; PG8_SCHED;
            PG8_LDB(B1, 1, 1); PG8_STAGE(PG8_SB(1, 0), b3, voffB);
            PG8_BAR; PG8_WAIT_L(0); PG8_MMA(0, 1, At, B1); PG8_BAR;
            PG8_LDA(At, 1, 1); PG8_STAGE(PG8_SA(1, 0), a3, voffA);
            PG8_BAR; PG8_WAIT_L(0); PG8_MMA(1, 0, At, B0); PG8_BAR; PG8_SCHED;
            PG8_STAGE(PG8_SB(1, 1), b3 + hstep, voffB);
            PG8_WAIT_V(6); PG8_BAR; PG8_MMA(1, 1, At, B1); PG8_BAR;
        }
        PG8_STAMP();
        if constexpr (!Epi::AFTER_DRAIN) { E(acc, cur, wr, wc, fr, fq); S.done(cur); }
        PG8_STAMP();
        if (!has_next) break;
#pragma unroll
        for (int a = 0; a < 2; ++a)
#pragma unroll
            for (int b = 0; b < 2; ++b)
#pragma unroll
                for (int m = 0; m < 4; ++m)
#pragma unroll
                    for (int n = 0; n < 2; ++n) acc[a][b][m][n] = (f32x4){0.f, 0.f, 0.f, 0.f};
        cur = nxt; cA = nA; cB = nB; ++ui;
    }
    PG8_WAIT_V(0);
    if (wr == 0) PG8_BAR;
    PG8_BAR;
    if constexpr (Epi::AFTER_DRAIN) { E.fused(acc, cur, wr, wc, fr, fq, lds, wid, lane); S.done(cur); }
    PG8_STAMP();
    if (STAMP && wid == 0) { stamps[lane] = lane < nts ? (((unsigned long long)(unsigned)ts_hi << 32) | (unsigned)ts_lo) : 0ull;
        if (lane == 62) stamps[62] = rt_entry; if (lane == 63) stamps[63] = (unsigned long long)wall_clock64(); }
#undef PG8_STAMP
#undef PG8_SA
#undef PG8_SB
#undef PG8_STAGE
#undef PG8_LDA
#undef PG8_LDB
#undef PG8_MMA
#undef PG8_WAIT_V
#undef PG8_WAIT_L
#undef PG8_BAR
#undef PG8_SCHED
}
}

#include <hip/hip_cooperative_groups.h>
namespace cg = cooperative_groups;
using pg8::bf16_t; using pg8::f32x4; using pg8::bf16x8; using pg8::u32x4; using pg8::Unit;
#define LAS __attribute__((address_space(3)))
#define DI __device__ __forceinline__
typedef float f32x16 __attribute__((ext_vector_type(16)));
typedef float f32x2v __attribute__((ext_vector_type(2)));
typedef __bf16 bf16x2n __attribute__((ext_vector_type(2)));
typedef unsigned u32x2 __attribute__((ext_vector_type(2)));

constexpr int D = 1024, NBATCH = 8, SEQL = 4096, T = NBATCH * SEQL, CL = 256, TC = NBATCH * CL, TT = T + TC, FF = 2816, LK = SEQL + CL;
constexpr float EPS = 1e-6f;
constexpr size_t MiB = 1048576;
constexpr size_t WS_WFF_IN0 = 0, WS_WFF_IN1 = 11 * MiB, WS_WFF_OUT0 = 22 * MiB, WS_WFF_OUT1 = 22 * MiB + MiB * 11 / 2, WS_WA = 33 * MiB, WS_WB = 41 * MiB, WS_WG = 45 * MiB,
                 WS_WHY = 49 * MiB, WS_WDA = 51 * MiB, WS_WO = 53 * MiB, WS_MOD = 55 * MiB, WS_H3 = 55 * MiB + MiB / 2, WS_ROPE = 56 * MiB + MiB / 2,
                 WS_XN = 58 * MiB, WS_ACT = 126 * MiB, WS_H = 313 * MiB, WS_ZT = 126 * MiB, WS_HYT = 382 * MiB, WS_Q = 126 * MiB, WS_K = 190 * MiB, WS_VT = 258 * MiB,
                 WS_HY = 190 * MiB, WS_BUFG = 254 * MiB, WS_MERGED = 318 * MiB, WS_Y = 382 * MiB, WS_GIMG = 446 * MiB, WS_END = 480 * MiB;
constexpr int IMGN = 16448, OFFO = 8224;
constexpr int LDS_BYTES = 131072 + 4096;

struct Params { const float* in[29]; float* out; unsigned char* ws; };

DI float bflo(unsigned w) { return __uint_as_float(w << 16); }
DI float bfhi(unsigned w) { return __uint_as_float(w & 0xffff0000u); }
DI float bf2f(unsigned short b) { return __uint_as_float(((unsigned)b) << 16); }
DI unsigned pk(float lo, float hi) { f32x2v v = {lo, hi}; bf16x2n b = __builtin_convertvector(v, bf16x2n); return __builtin_bit_cast(unsigned, b); }
DI unsigned short f2bf(float x) { return (unsigned short)(pk(x, 0.f) & 0xffffu); }
DI float shx(float v, int lane, int o) { return __int_as_float(__builtin_amdgcn_ds_bpermute((lane ^ o) << 2, __float_as_int(v))); }
DI float shl(float v, int src) { return __int_as_float(__builtin_amdgcn_ds_bpermute(src << 2, __float_as_int(v))); }
DI float wave_sum(float v, int lane) {
#pragma unroll
    for (int o = 32; o >= 1; o >>= 1) v += shx(v, lane, o);
    return v; }
DI float fast_exp2(float x) { return __builtin_amdgcn_exp2f(x); }
DI float siluf(float x) { return x / (1.0f + __expf(-x)); }
DI float sigmf(float x) { return 1.0f / (1.0f + __expf(-x)); }
DI int tid_opaque() { int t = threadIdx.x; asm volatile("" : "+v"(t)); return t; }
#define MFMA32(a, b, c) __builtin_amdgcn_mfma_f32_32x32x16_bf16((a), (b), (c), 0, 0, 0)

struct EpiSwiGLU {
    static constexpr bool PERM = true, AFTER_DRAIN = false;
    bf16_t* O;
    __device__ __forceinline__ void operator()(const f32x4 (&acc)[2][2][4][2], const Unit& u, int wr, int wc, int fr, int fq) const {
        const int row0 = u.pm * 256 + wr * 64 + fr, col0 = u.pn * 128 + wc * 32 + 8 * fq;
#pragma unroll
        for (int ai = 0; ai < 2; ++ai)
#pragma unroll
            for (int m = 0; m < 4; ++m) {
                bf16_t* rowp = O + (size_t)(row0 + ai * 128 + m * 16) * FF + col0;
                const f32x4 g0 = acc[ai][0][m][0], g1 = acc[ai][0][m][1], u0 = acc[ai][1][m][0], u1 = acc[ai][1][m][1];
                u32x4 w;
                w.x = pk(siluf(g0[0]) * u0[0], siluf(g0[1]) * u0[1]); w.y = pk(siluf(g0[2]) * u0[2], siluf(g0[3]) * u0[3]);
                w.z = pk(siluf(g1[0]) * u1[0], siluf(g1[1]) * u1[1]); w.w = pk(siluf(g1[2]) * u1[2], siluf(g1[3]) * u1[3]);
                *(u32x4*)rowp = w;
            }
    }
};
template <int MODE> struct EpiGen {
    static constexpr bool PERM = true, AFTER_DRAIN = false;
    bf16_t* O; long ldc; int rtpb; long rbstride; int rowoff; int ctpb; long cbstride; int coloff; const bf16_t* G; const float* rope; float scale;
    __device__ __forceinline__ void operator()(const f32x4 (&acc)[2][2][4][2], const Unit& u, int wr, int wc, int fr, int fq) const {
        const long rbase = (long)(u.pm / rtpb) * rbstride + (long)(u.pm % rtpb) * 256 + rowoff;
        const long cboff = (long)(u.pn / ctpb) * cbstride;
        const int cbase = (u.pn % ctpb) * 256 + coloff;
#pragma unroll
        for (int ai = 0; ai < 2; ++ai)
#pragma unroll
            for (int m = 0; m < 4; ++m) {
                const int rl = ai * 128 + wr * 64 + m * 16 + fr;
                const long row = rbase + rl;
                f32x4 cs0 = {1.f, 0.f, 1.f, 0.f}, cs1 = {1.f, 0.f, 1.f, 0.f};
                if (MODE == 1) {
                    const int t = (u.pm & 15) * 256 + rl;
                    const int pos = (wc & 1) ? (t & 63) : (t >> 6);
                    const float* rp = rope + pos * 32 + 8 * fq;
                    cs0 = *(const f32x4*)rp; cs1 = *(const f32x4*)(rp + 4);
                }
#pragma unroll
                for (int bj = 0; bj < 2; ++bj) {
                    const int col = cbase + bj * 128 + wc * 32 + 8 * fq;
                    const size_t off = (size_t)cboff + (size_t)row * ldc + col;
                    f32x4 v0 = acc[ai][bj][m][0], v1 = acc[ai][bj][m][1];
                    if (MODE == 1) {
                        f32x4 a, b;
                        a[0] = v0[0] * cs0[0] - v0[1] * cs0[1]; a[1] = v0[0] * cs0[1] + v0[1] * cs0[0];
                        a[2] = v0[2] * cs0[2] - v0[3] * cs0[3]; a[3] = v0[2] * cs0[3] + v0[3] * cs0[2];
                        b[0] = v1[0] * cs1[0] - v1[1] * cs1[1]; b[1] = v1[0] * cs1[1] + v1[1] * cs1[0];
                        b[2] = v1[2] * cs1[2] - v1[3] * cs1[3]; b[3] = v1[2] * cs1[3] + v1[3] * cs1[2];
                        v0 = a * scale; v1 = b * scale;
                    }
                    if (MODE == 2) {
#pragma unroll
                        for (int j = 0; j < 4; ++j) { v0[j] = sigmf(v0[j]); v1[j] = sigmf(v1[j]); }
                    }
                    if (MODE == 3 || MODE == 4) {
                        const u32x4 g = *(const u32x4*)(G + off);
                        v0[0] *= bflo(g.x); v0[1] *= bfhi(g.x); v0[2] *= bflo(g.y); v0[3] *= bfhi(g.y);
                        v1[0] *= bflo(g.z); v1[1] *= bfhi(g.z); v1[2] *= bflo(g.w); v1[3] *= bfhi(g.w);
                    }
                    if (MODE == 4) {
                        const u32x4 o = *(const u32x4*)(O + off);
                        v0[0] += bflo(o.x); v0[1] += bfhi(o.x); v0[2] += bflo(o.y); v0[3] += bfhi(o.y);
                        v1[0] += bflo(o.z); v1[1] += bfhi(o.z); v1[2] += bflo(o.w); v1[3] += bfhi(o.w);
                    }
                    u32x4 w; w.x = pk(v0[0], v0[1]); w.y = pk(v0[2], v0[3]); w.z = pk(v1[0], v1[1]); w.w = pk(v1[2], v1[3]);
                    *(u32x4*)(O + off) = w;
                }
            }
    }
};
template <int MODE> DI EpiGen<MODE> mk_epi(bf16_t* O, long ldc, const bf16_t* G = nullptr) {
    EpiGen<MODE> e; e.O = O; e.ldc = ldc; e.rtpb = 1 << 20; e.rbstride = 0; e.rowoff = 0; e.ctpb = 1 << 20; e.cbstride = 0; e.coloff = 0; e.G = G; e.rope = nullptr; e.scale = 1.f; return e; }

template <class Epi> DI void run_gemm(LAS unsigned char* lds, const bf16_t* A, const bf16_t* Bt, int M, int N, int K, const Epi& E) {
    pg8::Gemm g{A, Bt, M, N, K}; pg8::StaticOrder S; S.init(M, N, (int)gridDim.x, (int)blockIdx.x);
    pg8::gemm_phase<Epi, pg8::StaticOrder, false>(lds, g, S, E, nullptr);
}

DI int colmap(int w, int n) {
    switch (w) {
        case 0: case 1: { const int pn = n >> 8, rr = n & 255; return rr < 128 ? pn * 128 + rr : FF + pn * 128 + (rr - 128); }
        case 4: return n < 3072 ? n : 5120 + (n - 3072);
        case 5: { const int base = n < 1024 ? 3072 : 4096; const int x = n & 1023; const int hm = x >> 6, pp = x & 63; const int pi = pp >> 1, half = pp & 1, axis = pi >> 4, f = pi & 15;
                  return base + hm * 64 + axis * 32 + half * 16 + f; }
        case 6: return 6144 + n;
        default: return n;
    }
}
__device__ void p0_convert(const Params& p, unsigned char* shm) {
    float* tile = (float*)shm;
    const int tid = tid_opaque();
    for (int ti = blockIdx.x; ti < 7040; ti += gridDim.x) {
        int w, loc;
        if (ti < 1408) { w = 0; loc = ti; } else if (ti < 2816) { w = 1; loc = ti - 1408; } else if (ti < 3520) { w = 2; loc = ti - 2816; } else if (ti < 4224) { w = 3; loc = ti - 3520; }
        else if (ti < 5248) { w = 4; loc = ti - 4224; } else if (ti < 5760) { w = 5; loc = ti - 5248; } else if (ti < 6272) { w = 6; loc = ti - 5760; }
        else if (ti < 6528) { w = 7; loc = ti - 6272; } else if (ti < 6784) { w = 8; loc = ti - 6528; } else { w = 9; loc = ti - 6784; }
        const float* src; int ld, K; size_t dsto;
        switch (w) {
            case 0: src = p.in[7]; ld = 2 * FF; K = 1024; dsto = WS_WFF_IN0; break;
            case 1: src = p.in[7] + (size_t)1024 * 2 * FF; ld = 2 * FF; K = 1024; dsto = WS_WFF_IN1; break;
            case 2: src = p.in[8]; ld = 1024; K = FF; dsto = WS_WFF_OUT0; break;
            case 3: src = p.in[8] + (size_t)FF * 1024; ld = 1024; K = FF; dsto = WS_WFF_OUT1; break;
            case 4: src = p.in[9]; ld = 8192; K = 1024; dsto = WS_WA; break;
            case 5: src = p.in[9]; ld = 8192; K = 1024; dsto = WS_WB; break;
            case 6: src = p.in[9]; ld = 8192; K = 1024; dsto = WS_WG; break;
            case 7: src = p.in[26]; ld = 1024; K = 1024; dsto = WS_WHY; break;
            case 8: src = p.in[27]; ld = 1024; K = 1024; dsto = WS_WDA; break;
            default: src = p.in[28]; ld = 1024; K = 1024; dsto = WS_WO; break;
        }
        bf16_t* dst = (bf16_t*)(p.ws + dsto);
        const int kT = K >> 6, kt = loc % kT, nt = loc / kT, k0 = kt * 64, n0 = nt * 64;
        {
            const int nl = tid & 63, kq = tid >> 6; const int sc = colmap(w, n0 + nl);
#pragma unroll
            for (int i = 0; i < 8; ++i) { const int kl = kq + 8 * i; tile[kl * 65 + nl] = src[(size_t)(k0 + kl) * ld + sc]; }
        }
        __syncthreads();
        {
            const int nl = tid >> 3, kc = (tid & 7) * 8;
            u32x4 wv; float v[8];
#pragma unroll
            for (int j = 0; j < 8; ++j) v[j] = tile[(kc + j) * 65 + nl];
            wv.x = pk(v[0], v[1]); wv.y = pk(v[2], v[3]); wv.z = pk(v[4], v[5]); wv.w = pk(v[6], v[7]);
            *(u32x4*)(dst + (size_t)(n0 + nl) * K + k0 + kc) = wv;
        }
        __syncthreads();
    }
}
__device__ void p0_adaln(const Params& p, unsigned char* shm) {
    if (blockIdx.x >= 144) return;
    float* ssil = (float*)shm;
    float* red = ssil + 9 * 1024;
    const int tid = tid_opaque();
    const float* c = p.in[1]; const float* cctx = p.in[3]; const float* wada = p.in[4]; const float* bada = p.in[5];
    float* MOD = (float*)(p.ws + WS_MOD);
    for (int i = tid; i < 9216; i += 512) { const int b = i >> 10, k = i & 1023; const float v = b < 8 ? c[b * 1024 + k] : cctx[k]; ssil[i] = siluf(v); }
    __syncthreads();
    for (int u = blockIdx.x; u < 144; u += gridDim.x) {
        const int jl = tid & 63, kg = tid >> 6, j = u * 64 + jl;
        float a[9];
#pragma unroll
        for (int b = 0; b < 9; ++b) a[b] = 0.f;
        for (int k = kg * 128; k < kg * 128 + 128; ++k) {
            const float wv = wada[(size_t)k * 9216 + j];
#pragma unroll
            for (int b = 0; b < 9; ++b) a[b] += ssil[b * 1024 + k] * wv;
        }
#pragma unroll
        for (int b = 0; b < 9; ++b) red[(kg * 9 + b) * 64 + jl] = a[b];
        __syncthreads();
        for (int i = tid; i < 576; i += 512) {
            const int b = i >> 6, j2 = i & 63; float s = 0.f;
#pragma unroll
            for (int g = 0; g < 8; ++g) s += red[(g * 9 + b) * 64 + j2];
            MOD[b * 9216 + u * 64 + j2] = s + bada[u * 64 + j2];
        }
        __syncthreads();
    }
}
__device__ void p0_h3(const Params& p) {
    const int tid = tid_opaque(); const int lane = tid & 63, wave = tid >> 6;
    const float* w1 = p.in[12]; const float* b1 = p.in[13]; const float* w2 = p.in[14]; const float* b2 = p.in[15]; const float* w3 = p.in[16]; const float* b3 = p.in[17]; const float* freq = p.in[19];
    float* H3 = (float*)(p.ws + WS_H3);
    const float fr = freq[lane];
    for (int t = blockIdx.x * 8 + wave; t < SEQL; t += gridDim.x * 8) {
        const float tl = (float)t / 4095.0f;
        const float w = 6.283185307179586f * (float)t / 4096.0f;
        float z = 0.f;
        if (lane == 0) z = tl;
        else if (lane <= 16) { const float f = 1e-4f + (float)(lane - 1) * ((15.0f - 1e-4f) / 15.0f); z = cosf(f * w); }
        else if (lane <= 32) { const float f = 1e-4f + (float)(lane - 17) * ((15.0f - 1e-4f) / 15.0f); z = -sinf(f * w); }
        float h = b1[lane];
        for (int i = 0; i < 33; ++i) h += shl(z, i) * w1[i * 64 + lane];
        h = sinf(fr * h);
        float h2 = b2[lane];
        for (int i = 0; i < 64; ++i) h2 += shl(h, i) * w2[i * 64 + lane];
        h2 = sinf(fr * h2);
        float h3 = b3[lane];
        for (int i = 0; i < 64; ++i) h3 += shl(h2, i) * w3[i * 64 + lane];
        h3 = sinf(fr * h3);
        H3[t * 64 + lane] = h3;
    }
    if (blockIdx.x == gridDim.x - 1) {
        float* ROPE = (float*)(p.ws + WS_ROPE);
        for (int idx = tid; idx < 1024; idx += 512) {
            const int pos = idx >> 4, f = idx & 15;
            const float inv = powf(10000.0f, -(float)(2 * f) / 32.0f);
            const float ang = (float)pos * inv;
            ROPE[idx * 2] = cosf(ang); ROPE[idx * 2 + 1] = sinf(ang);
        }
    }
}
__device__ void p1_filter(const Params& p, unsigned char* shm) {
    float* vals = (float*)shm;
    float* w4s = (float*)(shm + 131072);
    float* red = w4s + 512;
    const int tid = tid_opaque(), lane = tid & 63, wave = tid >> 6;
    const float* w4 = p.in[18]; const float* H3 = (const float*)(p.ws + WS_H3);
    unsigned short* GIMG = (unsigned short*)(p.ws + WS_GIMG);
    for (int u = blockIdx.x; u < 256; u += gridDim.x) {
        const int c0 = u * 4;
        { const int ii = tid >> 3, q = tid & 7, cc = q >> 1, dir = q & 1; w4s[tid] = w4[(size_t)ii * 2048 + dir * 1024 + c0 + cc]; }
        __syncthreads();
        float sums[4] = {0.f, 0.f, 0.f, 0.f};
#pragma unroll 1
        for (int it = 0; it < 8; ++it) {
            const int t = tid + 512 * it;
            float a[8];
#pragma unroll
            for (int q = 0; q < 8; ++q) a[q] = 0.f;
            const f32x4* hp = (const f32x4*)(H3 + (size_t)t * 64);
#pragma unroll 2
            for (int i4 = 0; i4 < 16; ++i4) {
                const f32x4 hv = hp[i4];
#pragma unroll
                for (int e = 0; e < 4; ++e) {
                    const float* wr = w4s + (i4 * 4 + e) * 8;
#pragma unroll
                    for (int q = 0; q < 8; ++q) a[q] += hv[e] * wr[q];
                }
            }
            const float tl = (float)t / 4095.0f;
#pragma unroll
            for (int cc = 0; cc < 4; ++cc) {
                const float delta = 3.0701134573f + (float)(c0 + cc) * ((15.3505672866f - 3.0701134573f) / 1023.0f);
                const float dec = expf(-tl * delta);
                const float f = a[cc * 2] * dec, bwd = a[cc * 2 + 1] * dec;
                vals[t * 8 + cc * 2] = f; vals[t * 8 + cc * 2 + 1] = bwd;
                sums[cc] += fabsf(f) + (t >= 1 ? fabsf(bwd) : 0.f);
            }
        }
#pragma unroll
        for (int cc = 0; cc < 4; ++cc) { const float s = wave_sum(sums[cc], lane); if (lane == 0) red[wave * 4 + cc] = s; }
        __syncthreads();
        float inv[4];
#pragma unroll
        for (int cc = 0; cc < 4; ++cc) { float s = 0.f;
#pragma unroll
            for (int g = 0; g < 8; ++g) s += red[g * 4 + cc];
            inv[cc] = 1.0f / (s + EPS); }
#pragma unroll 1
        for (int it = 0; it < 8; ++it) {
            const int t = tid + 512 * it;
#pragma unroll
            for (int cc = 0; cc < 4; ++cc) {
                unsigned short* img = GIMG + (size_t)(c0 + cc) * IMGN;
                const unsigned short f = f2bf(vals[t * 8 + cc * 2] * inv[cc]), bb = f2bf(vals[t * 8 + cc * 2 + 1] * inv[cc]);
                const int pf = SEQL - t;
                img[pf] = f; img[OFFO + pf - 1] = f;
                if (t >= 1) { const int pb = SEQL + t; img[pb] = bb; img[OFFO + pb - 1] = bb; }
                else { img[0] = 0; img[OFFO + 8191] = 0; }
            }
        }
        __syncthreads();
    }
}
template <bool HAS_SRC, bool WRITE_RES, bool WRITE_XN>
__device__ void row_phase(const Params& p, const bf16_t* SRC, const float* res_lat, const float* res_ctx, float* RES_OUT, bf16_t* XN, int nrows,
                          const float* g_post, float gmul, int gate_idx, const float* g_pre, int shift_idx, int scale_idx) {
    const int tid = tid_opaque(); const int lane = tid & 63, wave = tid >> 6;
    const float* MOD = (const float*)(p.ws + WS_MOD);
    for (int row = blockIdx.x * 8 + wave; row < nrows; row += gridDim.x * 8) {
        const int b = row < T ? row / SEQL : 8;
        const float* rin = row < T ? res_lat + (size_t)row * D : res_ctx + (size_t)(row - T) * D;
        const float* mod = MOD + b * 9216;
        f32x4 v[4];
#pragma unroll
        for (int i = 0; i < 4; ++i) v[i] = *(const f32x4*)(rin + (i * 64 + lane) * 4);
        if (HAS_SRC) {
            f32x4 hsrc[4]; float ss = 0.f;
#pragma unroll
            for (int i = 0; i < 4; ++i) {
                const u32x2 w = *(const u32x2*)(SRC + (size_t)row * D + (i * 64 + lane) * 4);
                hsrc[i][0] = bflo(w.x); hsrc[i][1] = bfhi(w.x); hsrc[i][2] = bflo(w.y); hsrc[i][3] = bfhi(w.y);
                ss += hsrc[i][0] * hsrc[i][0] + hsrc[i][1] * hsrc[i][1] + hsrc[i][2] * hsrc[i][2] + hsrc[i][3] * hsrc[i][3];
            }
            ss = wave_sum(ss, lane);
            const float rstd = rsqrtf(ss * (1.0f / D) + EPS);
#pragma unroll
            for (int i = 0; i < 4; ++i) {
                const int col = (i * 64 + lane) * 4;
                const f32x4 gp = *(const f32x4*)(g_post + col), gt = *(const f32x4*)(mod + gate_idx * 1024 + col);
                v[i] += gmul * gt * (hsrc[i] * rstd * gp);
            }
        }
        if (WRITE_RES && row < T) {
#pragma unroll
            for (int i = 0; i < 4; ++i) *(f32x4*)(RES_OUT + (size_t)row * D + (i * 64 + lane) * 4) = v[i];
        }
        if (WRITE_XN) {
            float ss = 0.f;
#pragma unroll
            for (int i = 0; i < 4; ++i) ss += v[i][0] * v[i][0] + v[i][1] * v[i][1] + v[i][2] * v[i][2] + v[i][3] * v[i][3];
            ss = wave_sum(ss, lane);
            const float rstd = rsqrtf(ss * (1.0f / D) + EPS);
#pragma unroll
            for (int i = 0; i < 4; ++i) {
                const int col = (i * 64 + lane) * 4;
                const f32x4 gp = *(const f32x4*)(g_pre + col), sh = *(const f32x4*)(mod + shift_idx * 1024 + col), sc = *(const f32x4*)(mod + scale_idx * 1024 + col);
                const f32x4 y = (v[i] * rstd * gp) * (1.0f + sc) + sh;
                u32x2 w; w.x = pk(y[0], y[1]); w.y = pk(y[2], y[3]);
                *(u32x2*)(XN + (size_t)row * D + col) = w;
            }
        }
    }
}
DI void conv8(const bf16_t* prow, int t0, float w0, float w1, float w2, float bias, float (&out)[8]) {
    const u32x4 a = *(const u32x4*)(prow + t0);
    float x[10];
    x[0] = t0 > 0 ? bf2f(prow[t0 - 1]) : 0.f; x[9] = t0 + 8 < SEQL ? bf2f(prow[t0 + 8]) : 0.f;
    x[1] = bflo(a.x); x[2] = bfhi(a.x); x[3] = bflo(a.y); x[4] = bfhi(a.y); x[5] = bflo(a.z); x[6] = bfhi(a.z); x[7] = bflo(a.w); x[8] = bfhi(a.w);
#pragma unroll
    for (int j = 0; j < 8; ++j) out[j] = w0 * x[j] + w1 * x[j + 1] + w2 * x[j + 2] + bias;
}
__device__ void hyena_phase(const Params& p, LAS unsigned char* lds) {
    const int tid = tid_opaque(), lane = tid & 63, wave = __builtin_amdgcn_readfirstlane(tid >> 6), r = lane & 31, h = lane >> 5;
    const bf16_t* ZT = (const bf16_t*)(p.ws + WS_ZT); const unsigned short* GIMG = (const unsigned short*)(p.ws + WS_GIMG); bf16_t* HYT = (bf16_t*)(p.ws + WS_HYT);
    const float* cw = p.in[10]; const float* cb = p.in[11]; const float* hyb = p.in[20];
    constexpr int UROW = 8704, IOFF = 69632;
    for (int c = blockIdx.x; c < 1024; c += gridDim.x) {
        { const u32x4* src = (const u32x4*)(GIMG + (size_t)c * IMGN); for (int i = tid; i < IMGN / 8; i += 512) *(LAS u32x4*)(lds + IOFF + i * 16) = src[i]; }
        {
            const float wx0 = cw[1024 + c], wx1 = cw[3072 + 1024 + c], wx2 = cw[6144 + 1024 + c], bx = cb[1024 + c];
            const float wv0 = cw[2048 + c], wv1 = cw[3072 + 2048 + c], wv2 = cw[6144 + 2048 + c], bv = cb[2048 + c];
#pragma unroll 2
            for (int it = 0; it < 8; ++it) {
                const int idx8 = it * 512 + tid, b = idx8 >> 9, t0 = (idx8 & 511) * 8;
                float x1c[8], vc[8];
                conv8(ZT + (size_t)(1024 + c) * T + b * SEQL, t0, wx0, wx1, wx2, bx, x1c);
                conv8(ZT + (size_t)(2048 + c) * T + b * SEQL, t0, wv0, wv1, wv2, bv, vc);
                u32x4 w; w.x = pk(vc[0] * x1c[0], vc[1] * x1c[1]); w.y = pk(vc[2] * x1c[2], vc[3] * x1c[3]); w.z = pk(vc[4] * x1c[4], vc[5] * x1c[5]); w.w = pk(vc[6] * x1c[6], vc[7] * x1c[7]);
                *(LAS u32x4*)(lds + b * UROW + (t0 >> 7) * 272 + (t0 & 127) * 2) = w;
            }
        }
        __syncthreads();
        f32x16 acc[4];
#pragma unroll
        for (int mi = 0; mi < 4; ++mi)
#pragma unroll
            for (int i = 0; i < 16; ++i) acc[mi][i] = 0.f;
        const LAS unsigned* img32 = (const LAS unsigned*)(lds + IOFF);
        const int wl = ((r & 1) ? (OFFO / 2) : 0) + ((SEQL - r + 8 * h - (r & 1)) >> 1);
        for (int db = -31; db <= 31; ++db) {
            bf16x8 A[14];
            const LAS unsigned* ab = img32 + (wl - 64 * db);
#pragma unroll
            for (int o = 0; o < 14; ++o) { const LAS unsigned* q = ab - 8 * (o - 7); u32x4 w; w.x = q[0]; w.y = q[1]; w.z = q[2]; w.w = q[3]; A[o] = __builtin_bit_cast(bf16x8, w); }
            const int sb = r - db; const bool valid = (unsigned)sb < 32u;
            const LAS unsigned char* ub = lds + wave * UROW + (valid ? sb : 0) * 272 + h * 16;
#pragma unroll
            for (int ks = 0; ks < 8; ++ks) {
                u32x4 bw = *(const LAS u32x4*)(ub + ks * 32);
                if (!valid) { bw.x = 0; bw.y = 0; bw.z = 0; bw.w = 0; }
                const bf16x8 B = __builtin_bit_cast(bf16x8, bw);
#pragma unroll
                for (int mi = 0; mi < 4; ++mi) acc[mi] = MFMA32(A[2 * mi - ks + 7], B, acc[mi]);
            }
        }
        {
            const float hb = hyb[c];
#pragma unroll
            for (int mi = 0; mi < 4; ++mi)
#pragma unroll
                for (int g4 = 0; g4 < 4; ++g4) {
                    const int i0 = 32 * mi + 8 * g4 + 4 * h;
                    LAS unsigned* up = (LAS unsigned*)(lds + wave * UROW + r * 272 + i0 * 2);
                    const unsigned w0 = up[0], w1 = up[1];
                    const float y0 = acc[mi][4 * g4 + 0] + bflo(w0) * hb, y1 = acc[mi][4 * g4 + 1] + bfhi(w0) * hb, y2 = acc[mi][4 * g4 + 2] + bflo(w1) * hb, y3 = acc[mi][4 * g4 + 3] + bfhi(w1) * hb;
                    up[0] = pk(y0, y1); up[1] = pk(y2, y3);
                }
        }
        __syncthreads();
        {
            const float w0 = cw[c], w1 = cw[3072 + c], w2 = cw[6144 + c], bb = cb[c];
#pragma unroll 2
            for (int it = 0; it < 8; ++it) {
                const int idx8 = it * 512 + tid, b = idx8 >> 9, t0 = (idx8 & 511) * 8;
                float x0c[8];
                conv8(ZT + (size_t)c * T + b * SEQL, t0, w0, w1, w2, bb, x0c);
                const u32x4 y = *(const LAS u32x4*)(lds + b * UROW + (t0 >> 7) * 272 + (t0 & 127) * 2);
                u32x4 w; w.x = pk(bflo(y.x) * x0c[0], bfhi(y.x) * x0c[1]); w.y = pk(bflo(y.y) * x0c[2], bfhi(y.y) * x0c[3]);
                w.z = pk(bflo(y.z) * x0c[4], bfhi(y.z) * x0c[5]); w.w = pk(bflo(y.w) * x0c[6], bfhi(y.w) * x0c[7]);
                *(u32x4*)(HYT + (size_t)c * T + b * SEQL + t0) = w;
            }
        }
        __syncthreads();
    }
}
__device__ void transpose_phase(const Params& p, unsigned char* shm) {
    unsigned short* tile = (unsigned short*)shm;
    const bf16_t* HYT = (const bf16_t*)(p.ws + WS_HYT); bf16_t* HY = (bf16_t*)(p.ws + WS_HY);
    const int tid = tid_opaque();
    for (int ti = blockIdx.x; ti < 16 * 512; ti += gridDim.x) {
        const int ct = ti & 15, tt = ti >> 4, c0 = ct * 64, t0 = tt * 64;
        { const int cl = tid >> 3, ch = tid & 7; const u32x4 v = *(const u32x4*)(HYT + (size_t)(c0 + cl) * T + t0 + ch * 8); *(u32x4*)(tile + cl * 72 + ch * 8) = v; }
        __syncthreads();
        { const int tl = tid >> 3, cc = (tid & 7) * 8; unsigned short e[8];
#pragma unroll
          for (int j = 0; j < 8; ++j) e[j] = tile[(cc + j) * 72 + tl];
          u32x4 w; w.x = e[0] | ((unsigned)e[1] << 16); w.y = e[2] | ((unsigned)e[3] << 16); w.z = e[4] | ((unsigned)e[5] << 16); w.w = e[6] | ((unsigned)e[7] << 16);
          *(u32x4*)(HY + (size_t)(t0 + tl) * D + c0 + cc) = w; }
        __syncthreads();
    }
}
DI bf16x8 pack8(const f32x16& s, int base) {
    u32x4 w; w.x = pk(s[base + 0], s[base + 1]); w.y = pk(s[base + 2], s[base + 3]); w.z = pk(s[base + 4], s[base + 5]); w.w = pk(s[base + 6], s[base + 7]);
    return __builtin_bit_cast(bf16x8, w);
}
__device__ void attn_phase(const Params& p, LAS unsigned char* lds) {
    const int tid = tid_opaque(), lane = tid & 63, wave = __builtin_amdgcn_readfirstlane(tid >> 6), r = lane & 31, h = lane >> 5, map = wave >> 2, qw = wave & 3;
    float lam;
    { float a1 = p.in[21][lane] * p.in[22][lane], a2 = p.in[23][lane] * p.in[24][lane]; a1 = wave_sum(a1, lane); a2 = wave_sum(a2, lane); lam = expf(a1) - expf(a2) + 0.2f; }
    bf16_t* Q = (bf16_t*)(p.ws + WS_Q); const bf16_t* K = (const bf16_t*)(p.ws + WS_K); const bf16_t* VT = (const bf16_t*)(p.ws + WS_VT);
    const float* subg = p.in[25];
    constexpr int VOFF = 17408, BUFSZ = 34816, OOFF = 67584, NKT = LK / 64;
    const int G = gridDim.x, bx = blockIdx.x;
    const int vcu = (G % 8 == 0) ? (bx % 8) * (G / 8) + bx / 8 : bx;
    const int kkey0 = tid >> 4, kch = tid & 15;
    const int ve0 = tid >> 3, vch = tid & 7;
    for (int u = vcu; u < 2048; u += G) {
        const int b = u >> 8, hd = (u >> 5) & 7, qb = u & 31;
        const bf16_t* qp = Q + ((size_t)(b * SEQL + qb * 128 + qw * 32 + r)) * D + hd * 128 + map * 64 + 8 * h;
        bf16x8 qf[4];
#pragma unroll
        for (int ks = 0; ks < 4; ++ks) qf[ks] = *(const bf16x8*)(qp + 16 * ks);
        const bf16_t* kg = K + (size_t)b * LK * D + hd * 128 + (size_t)kkey0 * D + kch * 8;
        const bf16_t* vg = VT + ((size_t)b * D + hd * 128 + ve0) * LK + vch * 8;
        u32x4 pk0, pk1, pv0, pv1;
        pk0 = *(const u32x4*)(kg); pk1 = *(const u32x4*)(kg + (size_t)32 * D);
        pv0 = *(const u32x4*)(vg); pv1 = *(const u32x4*)(vg + (size_t)64 * LK);
        {
            LAS unsigned char* nb = lds;
            *(LAS u32x4*)(nb + kkey0 * 272 + kch * 16) = pk0; *(LAS u32x4*)(nb + (kkey0 + 32) * 272 + kch * 16) = pk1;
            LAS unsigned char* v0p = nb + VOFF + ve0 * 136 + vch * 16; LAS unsigned char* v1p = nb + VOFF + (ve0 + 64) * 136 + vch * 16;
            *(LAS u32x2*)(v0p) = (u32x2){pv0.x, pv0.y}; *(LAS u32x2*)(v0p + 8) = (u32x2){pv0.z, pv0.w};
            *(LAS u32x2*)(v1p) = (u32x2){pv1.x, pv1.y}; *(LAS u32x2*)(v1p + 8) = (u32x2){pv1.z, pv1.w};
        }
        __syncthreads();
        float m_run = -1e30f, l_run = 0.f;
        f32x16 o[4];
#pragma unroll
        for (int mt = 0; mt < 4; ++mt)
#pragma unroll
            for (int i = 0; i < 16; ++i) o[mt][i] = 0.f;
        for (int kt = 0; kt < NKT; ++kt) {
            const LAS unsigned char* cur = lds + (kt & 1) * BUFSZ;
            const bool more = kt + 1 < NKT;
            if (more) {
                const bf16_t* kn = kg + (size_t)(kt + 1) * 64 * D; const bf16_t* vn = vg + (kt + 1) * 64;
                pk0 = *(const u32x4*)(kn); pk1 = *(const u32x4*)(kn + (size_t)32 * D);
                pv0 = *(const u32x4*)(vn); pv1 = *(const u32x4*)(vn + (size_t)64 * LK);
            }
            f32x16 s0, s1;
#pragma unroll
            for (int i = 0; i < 16; ++i) { s0[i] = 0.f; s1[i] = 0.f; }
            const LAS unsigned char* kb = cur + r * 272 + map * 128 + h * 16;
#pragma unroll
            for (int ks = 0; ks < 4; ++ks) {
                const bf16x8 kf0 = *(const LAS bf16x8*)(kb + ks * 32);
                const bf16x8 kf1 = *(const LAS bf16x8*)(kb + 32 * 272 + ks * 32);
                s0 = MFMA32(kf0, qf[ks], s0); s1 = MFMA32(kf1, qf[ks], s1);
            }
            __builtin_amdgcn_sched_barrier(0);
            float mx = s0[0];
#pragma unroll
            for (int i = 1; i < 16; ++i) mx = fmaxf(mx, s0[i]);
#pragma unroll
            for (int i = 0; i < 16; ++i) mx = fmaxf(mx, s1[i]);
            mx = fmaxf(mx, shx(mx, lane, 32));
            const float mnew = fmaxf(m_run, mx);
            const float alpha = fast_exp2(m_run - mnew);
            m_run = mnew;
            float ls = 0.f;
#pragma unroll
            for (int i = 0; i < 16; ++i) { s0[i] = fast_exp2(s0[i] - mnew); ls += s0[i]; }
#pragma unroll
            for (int i = 0; i < 16; ++i) { s1[i] = fast_exp2(s1[i] - mnew); ls += s1[i]; }
            l_run = l_run * alpha + ls;
#pragma unroll
            for (int mt = 0; mt < 4; ++mt) o[mt] *= alpha;
            const LAS unsigned char* vb = cur + VOFF + r * 136 + h * 8;
            __builtin_amdgcn_sched_barrier(0);
#pragma unroll
            for (int s4 = 0; s4 < 4; ++s4) {
                const bf16x8 pf = (s4 < 2) ? pack8(s0, (s4 & 1) * 8) : pack8(s1, (s4 & 1) * 8);
#pragma unroll
                for (int mt = 0; mt < 4; ++mt) {
                    const LAS unsigned char* vp = vb + mt * 32 * 136 + s4 * 32;
                    const u32x2 lo = *(const LAS u32x2*)vp, hi = *(const LAS u32x2*)(vp + 16);
                    u32x4 vw; vw.x = lo.x; vw.y = lo.y; vw.z = hi.x; vw.w = hi.y;
                    o[mt] = MFMA32(__builtin_bit_cast(bf16x8, vw), pf, o[mt]);
                }
            }
            if (more) {
                LAS unsigned char* nb = lds + ((kt + 1) & 1) * BUFSZ;
                *(LAS u32x4*)(nb + kkey0 * 272 + kch * 16) = pk0; *(LAS u32x4*)(nb + (kkey0 + 32) * 272 + kch * 16) = pk1;
                LAS unsigned char* v0p = nb + VOFF + ve0 * 136 + vch * 16; LAS unsigned char* v1p = nb + VOFF + (ve0 + 64) * 136 + vch * 16;
                *(LAS u32x2*)(v0p) = (u32x2){pv0.x, pv0.y}; *(LAS u32x2*)(v0p + 8) = (u32x2){pv0.z, pv0.w};
                *(LAS u32x2*)(v1p) = (u32x2){pv1.x, pv1.y}; *(LAS u32x2*)(v1p + 8) = (u32x2){pv1.z, pv1.w};
            }
            __syncthreads();
        }
        const float ltot = l_run + shx(l_run, lane, 32);
        const float invl = 1.0f / ltot;
        const int ql = qw * 32 + r;
        if (map == 1) {
            const float sc = invl * lam;
#pragma unroll
            for (int mt = 0; mt < 4; ++mt)
#pragma unroll
                for (int g4 = 0; g4 < 4; ++g4) {
                    const int e0 = 32 * mt + 8 * g4 + 4 * h;
                    f32x4 w; w[0] = o[mt][4 * g4] * sc; w[1] = o[mt][4 * g4 + 1] * sc; w[2] = o[mt][4 * g4 + 2] * sc; w[3] = o[mt][4 * g4 + 3] * sc;
                    *(LAS f32x4*)(lds + (ql * 132 + e0) * 4) = w;
                }
        }
        __syncthreads();
        if (map == 0) {
            float ss = 0.f;
#pragma unroll
            for (int mt = 0; mt < 4; ++mt)
#pragma unroll
                for (int g4 = 0; g4 < 4; ++g4) {
                    const int e0 = 32 * mt + 8 * g4 + 4 * h;
                    const f32x4 w = *(const LAS f32x4*)(lds + (ql * 132 + e0) * 4);
#pragma unroll
                    for (int j = 0; j < 4; ++j) { const float v = o[mt][4 * g4 + j] * invl - w[j]; o[mt][4 * g4 + j] = v; ss += v * v; }
                }
            ss += shx(ss, lane, 32);
            const float rstd = rsqrtf(ss * (1.0f / 128.0f) + EPS) * 0.8f;
#pragma unroll
            for (int mt = 0; mt < 4; ++mt)
#pragma unroll
                for (int g4 = 0; g4 < 4; ++g4) {
                    const int e0 = 32 * mt + 8 * g4 + 4 * h;
                    const f32x4 sg = *(const f32x4*)(subg + e0);
                    u32x2 w; w.x = pk(o[mt][4 * g4] * rstd * sg[0], o[mt][4 * g4 + 1] * rstd * sg[1]); w.y = pk(o[mt][4 * g4 + 2] * rstd * sg[2], o[mt][4 * g4 + 3] * rstd * sg[3]);
                    *(LAS u32x2*)(lds + OOFF + ql * 272 + e0 * 2) = w;
                }
        }
        __syncthreads();
#pragma unroll
        for (int i = 0; i < 4; ++i) {
            const int cid = tid + 512 * i, row = cid >> 4, ch = cid & 15;
            const u32x4 w = *(const LAS u32x4*)(lds + OOFF + row * 272 + ch * 16);
            *(u32x4*)(Q + ((size_t)(b * SEQL + qb * 128 + row)) * D + hd * 128 + ch * 8) = w;
        }
        __syncthreads();
    }
}

__global__ void __launch_bounds__(512, 2) mega_fwd(Params p) {
    extern __shared__ __attribute__((aligned(16))) unsigned char shm[];
    cg::grid_group grid = cg::this_grid();
    LAS unsigned char* lds = (LAS unsigned char*)shm;
    unsigned char* ws = p.ws;
    const float* x = p.in[0]; const float* ctx = p.in[2]; const float* ng = p.in[6];
    bf16_t* XN = (bf16_t*)(ws + WS_XN); bf16_t* ACT = (bf16_t*)(ws + WS_ACT); bf16_t* H = (bf16_t*)(ws + WS_H);
    bf16_t* ZT = (bf16_t*)(ws + WS_ZT); bf16_t* Qb = (bf16_t*)(ws + WS_Q); bf16_t* Kb = (bf16_t*)(ws + WS_K); bf16_t* VTb = (bf16_t*)(ws + WS_VT);
    bf16_t* HY = (bf16_t*)(ws + WS_HY); bf16_t* BUFG = (bf16_t*)(ws + WS_BUFG); bf16_t* MERGED = (bf16_t*)(ws + WS_MERGED); bf16_t* Y = (bf16_t*)(ws + WS_Y);
    const bf16_t* WA = (const bf16_t*)(ws + WS_WA); const bf16_t* WB = (const bf16_t*)(ws + WS_WB); const bf16_t* WG = (const bf16_t*)(ws + WS_WG);
    const float* ROPE = (const float*)(ws + WS_ROPE);

    p0_adaln(p, shm);
    p0_h3(p);
    p0_convert(p, shm);
    grid.sync();
    row_phase<false, false, true>(p, nullptr, x, ctx, nullptr, XN, TT, nullptr, 0.f, 0, ng + 0 * D, 0, 1);
    p1_filter(p, shm);
    grid.sync();
    { EpiSwiGLU E{ACT}; run_gemm(lds, XN, (const bf16_t*)(ws + WS_WFF_IN0), TT, 2 * FF, D, E); }
    grid.sync();
    { auto E = mk_epi<0>(H, D); run_gemm(lds, ACT, (const bf16_t*)(ws + WS_WFF_OUT0), TT, D, FF, E); }
    grid.sync();
    row_phase<true, true, true>(p, H, x, ctx, p.out, XN, TT, ng + 1 * D, 0.5f, 2, ng + 2 * D, 3, 4);
    grid.sync();
    { auto E = mk_epi<0>(ZT, T); run_gemm(lds, WA, XN, 3072, T, D, E); }
    grid.sync();
    hyena_phase(p, lds);
    grid.sync();
    { auto E = mk_epi<0>(VTb, LK); E.ctpb = 16; E.cbstride = (long)D * LK; run_gemm(lds, WA + (size_t)3072 * D, XN, 1024, T, D, E); }
    { auto E = mk_epi<0>(VTb, LK); E.ctpb = 1; E.cbstride = (long)D * LK; E.coloff = SEQL; run_gemm(lds, WA + (size_t)3072 * D, XN + (size_t)T * D, 1024, TC, D, E); }
    { auto E = mk_epi<1>(Qb, D); E.rope = ROPE; E.scale = 0.125f * 1.4426950408889634f; run_gemm(lds, XN, WB, T, 1024, D, E); }
    { auto E = mk_epi<1>(Kb, D); E.rope = ROPE; E.scale = 1.0f; E.rtpb = 16; E.rbstride = LK; run_gemm(lds, XN, WB + (size_t)1024 * D, T, 1024, D, E); }
    { auto E = mk_epi<0>(Kb, D); E.rtpb = 1; E.rbstride = LK; E.rowoff = SEQL; run_gemm(lds, XN + (size_t)T * D, WB + (size_t)1024 * D, TC, 1024, D, E); }
    grid.sync();
    attn_phase(p, lds);
    grid.sync();
    transpose_phase(p, shm);
    grid.sync();
    { auto E = mk_epi<2>(BUFG, D); run_gemm(lds, XN, WG, T, 1024, D, E); }
    { auto E = mk_epi<3>(MERGED, D, BUFG); run_gemm(lds, HY, (const bf16_t*)(ws + WS_WHY), T, 1024, D, E); }
    { auto E = mk_epi<2>(BUFG, D); run_gemm(lds, XN, WG + (size_t)1024 * D, T, 1024, D, E); }
    { auto E = mk_epi<4>(MERGED, D, BUFG); run_gemm(lds, Qb, (const bf16_t*)(ws + WS_WDA), T, 1024, D, E); }
    grid.sync();
    { auto E = mk_epi<0>(Y, D); run_gemm(lds, MERGED, (const bf16_t*)(ws + WS_WO), T, 1024, D, E); }
    grid.sync();
    row_phase<true, true, true>(p, Y, p.out, nullptr, p.out, XN, T, ng + 3 * D, 1.0f, 5, ng + 4 * D, 6, 7);
    grid.sync();
    { EpiSwiGLU E{ACT}; run_gemm(lds, XN, (const bf16_t*)(ws + WS_WFF_IN1), T, 2 * FF, D, E); }
    grid.sync();
    { auto E = mk_epi<0>(H, D); run_gemm(lds, ACT, (const bf16_t*)(ws + WS_WFF_OUT1), T, D, FF, E); }
    grid.sync();
    row_phase<true, true, false>(p, H, p.out, nullptr, p.out, nullptr, T, ng + 5 * D, 0.5f, 8, nullptr, 0, 0);
}

extern "C" void kernel_launch(void* const* d_in, const int* in_sizes, int n_in, void* d_out, int out_size, void* d_ws, size_t ws_size, hipStream_t stream) {
    static int grid_blocks = 0;
    if (!grid_blocks) {
        if (n_in != 29 || ws_size < WS_END) { fprintf(stderr, "kernel_launch: unexpected inputs (n_in %d, ws %zu)\n", n_in, ws_size); grid_blocks = -1; return; }
        int dev = 0, cus = 0, per_cu = 0;
        hipGetDevice(&dev);
        hipDeviceGetAttribute(&cus, hipDeviceAttributeMultiprocessorCount, dev);
        if (hipFuncSetAttribute((const void*)mega_fwd, hipFuncAttributeMaxDynamicSharedMemorySize, LDS_BYTES) != hipSuccess) { fprintf(stderr, "kernel_launch: hipFuncSetAttribute failed\n"); grid_blocks = -1; return; }
        hipOccupancyMaxActiveBlocksPerMultiprocessor(&per_cu, (const void*)mega_fwd, 512, LDS_BYTES);
        if (per_cu < 1) { fprintf(stderr, "kernel_launch: occupancy query returned %d\n", per_cu); per_cu = 1; }
        grid_blocks = cus * per_cu;
    }
    if (grid_blocks < 0) return;
    Params p{};
    for (int i = 0; i < 29; ++i) p.in[i] = (const float*)d_in[i];
    p.out = (float*)d_out; p.ws = (unsigned char*)d_ws;
    void* args[] = {&p};
    hipError_t e = hipLaunchCooperativeKernel((const void*)mega_fwd, dim3(grid_blocks), dim3(512), args, LDS_BYTES, stream);
    if (e != hipSuccess) fprintf(stderr, "kernel_launch: cooperative launch failed: %s (grid %d)\n", hipGetErrorString(e), grid_blocks);
}
```

```cpp
#include <hip/hip_runtime.h>
#include <cstdio>
namespace pg8 {
#define PG8_LAS __attribute__((address_space(3)))
typedef unsigned short bf16_t;
typedef short bf16x8 __attribute__((ext_vector_type(8)));
typedef float f32x4 __attribute__((ext_vector_type(4)));
typedef unsigned u32x4 __attribute__((ext_vector_type(4)));
constexpr int BM = 256, BK = 64, HALF = 128, HTB = HALF * BK * 2  , STAGE_BYTES = 8 * HTB, NXCD = 8, WGM = 8;

__host__ __device__ __forceinline__ int lds_byte(int r, int c) { const int st = (r >> 4) * 2 + (c >> 5), rr = r & 15, cc = c & 31, ob = rr * 64 + cc * 2; return st * 1024 + (ob ^ (((ob >> 9) & 1) << 5)); }
__host__ __device__ __forceinline__ void stage_rc(int b, int& R, int& C) { const int st = b / 1024, sb = b % 1024, swz = sb ^ (((sb >> 9) & 1) << 5); R = (st >> 1) * 16 + swz / 64; C = (st & 1) * 32 + (swz % 64) / 2; }
__host__ __device__ __forceinline__ int perm32(int rho) { const int n = rho >> 4, i = rho & 15; return 8 * (i >> 2) + 4 * n + (i & 3); }

struct Unit { int pm, pn; };
struct Gemm { const bf16_t* A; const bf16_t* Bt; int M, N, K; };

struct StaticOrder {
    int nM, nN, nwg, G, c;
    __host__ __device__ void init(int M, int N, int G_, int c_) { nM = M / BM; nN = N / BM; nwg = nM * nN; G = G_; c = c_; }
    __host__ __device__ bool next(int i, Unit& u) const {
        const long L = (long)i * G + c; if (L >= nwg) return false;
        int wgid = (int)L; { const int q = nwg / NXCD, r = nwg % NXCD, xcd = wgid % NXCD, off = wgid / NXCD; wgid = (xcd < r ? xcd * (q + 1) : r * (q + 1) + (xcd - r) * q) + off; }
        const int nig = WGM * nN, gid = wgid / nig, fm = gid * WGM, gsz = (nM - fm) < WGM ? (nM - fm) : WGM;
        u.pm = fm + ((wgid % nig) % gsz); u.pn = (wgid % nig) / gsz; return true;
    }
    __device__ __forceinline__ void a_ready(const Unit&) const {}
    __device__ __forceinline__ void done(const Unit&) const {}
};
__device__ __forceinline__ unsigned cvt_pk_bf16(float lo, float hi) { unsigned r; asm volatile("v_cvt_pk_bf16_f32 %0, %1, %2" : "=v"(r) : "v"(lo), "v"(hi)); return r; }
typedef float f32x2 __attribute__((ext_vector_type(2)));
template <class Epi, class Sched, bool STAMP = false>
__device__ __forceinline__ void gemm_phase(PG8_LAS unsigned char* lds, const Gemm g, const Sched& S, const Epi& E, unsigned long long* stamps) {
    int tid_ = threadIdx.x; asm volatile("" : "+v"(tid_)); const int tid = tid_, wid = __builtin_amdgcn_readfirstlane(tid >> 6), lane = tid & 63, wr = wid >> 2, wc = wid & 3, fr = lane & 15, fq = lane >> 4;
    const int K = g.K, nt = K / BK;
    int ts_lo = 0, ts_hi = 0, nts = 0; const unsigned long long rt_entry = STAMP ? (unsigned long long)wall_clock64() : 0ull;
#define PG8_STAMP() do { if (STAMP && wid == 0 && nts < 64) { const unsigned long long _c = (unsigned long long)clock64(); \
        ts_lo = (lane == nts) ? (int)(unsigned)_c : ts_lo; ts_hi = (lane == nts) ? (int)(unsigned)(_c >> 32) : ts_hi; ++nts; } } while (0)
    PG8_STAMP();
    unsigned voffA[2], voffB[2];
#pragma unroll
    for (int i = 0; i < 2; ++i) { int R, C; stage_rc(tid * 16 + i * 8192, R, C); const int Rb = Epi::PERM ? ((R & ~31) + perm32(R & 31)) : R;
        voffA[i] = (unsigned)(R * K + C) * 2u; voffB[i] = (unsigned)(Rb * K + C) * 2u; }
    const size_t kstep = (size_t)(BK * 2);
    const size_t hstep = (size_t)HALF * K * 2;
    const size_t tstep = 2 * hstep;
    const unsigned ldsw = (unsigned)wid * 1024u;
    const int aoff = lds_byte(wr * 64 + fr, fq * 8), boff = lds_byte(wc * 32 + fr, fq * 8);
#define PG8_SA(b, h) (((b) * 2 + (h)) * HTB)
#define PG8_SB(b, h) ((4 + (b) * 2 + (h)) * HTB)
#define PG8_STAGE(bufoff, gbase, voff) do { _Pragma("unroll") for (int _i = 0; _i < 2; ++_i) \
        __builtin_amdgcn_global_load_lds((const unsigned*)((const char*)(gbase) + (voff)[_i]), (PG8_LAS unsigned*)(lds + (bufoff) + ldsw + _i * 8192), 16, 0, 0); } while (0)
#define PG8_LDA(dst, b, h) do { _Pragma("unroll") for (int m = 0; m < 4; ++m) _Pragma("unroll") for (int k = 0; k < 2; ++k) dst[m][k] = *(const PG8_LAS bf16x8*)(lds + PG8_SA(b, h) + aoff + m * 2048 + k * 1024); } while (0)
#define PG8_LDB(dst, b, h) do { _Pragma("unroll") for (int n = 0; n < 2; ++n) _Pragma("unroll") for (int k = 0; k < 2; ++k) dst[n][k] = *(const PG8_LAS bf16x8*)(lds + PG8_SB(b, h) + boff + n * 2048 + k * 1024); } while (0)
#define PG8_MMA(ai, bj, At, Bt) do { __builtin_amdgcn_s_setprio(1); _Pragma("unroll") for (int m = 0; m < 4; ++m) _Pragma("unroll") for (int n = 0; n < 2; ++n) _Pragma("unroll") for (int k = 0; k < 2; ++k) \
        acc[ai][bj][m][n] = __builtin_amdgcn_mfma_f32_16x16x32_bf16(Bt[n][k], At[m][k], acc[ai][bj][m][n], 0, 0, 0); __builtin_amdgcn_s_setprio(0); } while (0)
#define PG8_WAIT_V(n) asm volatile("s_waitcnt vmcnt(" #n ")" ::: "memory")
#define PG8_WAIT_L(n) asm volatile("s_waitcnt lgkmcnt(" #n ")" ::: "memory")
#define PG8_BAR __builtin_amdgcn_s_barrier()
#define PG8_SCHED __builtin_amdgcn_sched_barrier(0)
    Unit cur, nxt; int ui = 0;
    if (!S.next(0, cur)) return;
    f32x4 acc[2][2][4][2];
#pragma unroll
    for (int a = 0; a < 2; ++a)
#pragma unroll
        for (int b = 0; b < 2; ++b)
#pragma unroll
            for (int m = 0; m < 4; ++m)
#pragma unroll
                for (int n = 0; n < 2; ++n) acc[a][b][m][n] = (f32x4){0.f, 0.f, 0.f, 0.f};
    bf16x8 At[4][2], B0[2][2], B1[2][2];
    const char* cA = (const char*)g.A + (size_t)cur.pm * tstep; const char* cB = (const char*)g.Bt + (size_t)cur.pn * tstep;
    S.a_ready(cur);
    PG8_STAGE(PG8_SB(0, 0), cB, voffB); PG8_STAGE(PG8_SA(0, 0), cA, voffA); PG8_STAGE(PG8_SB(0, 1), cB + hstep, voffB); PG8_STAGE(PG8_SA(0, 1), cA + hstep, voffA);
    if (wr == 1) PG8_BAR;
    PG8_WAIT_V(4); PG8_BAR;
    PG8_STAGE(PG8_SB(1, 0), cB + kstep, voffB); PG8_STAGE(PG8_SA(1, 0), cA + kstep, voffA); PG8_STAGE(PG8_SB(1, 1), cB + hstep + kstep, voffB);
    PG8_WAIT_V(6); PG8_BAR;
    PG8_STAMP();
    for (;;) {
        const bool has_next = S.next(ui + 1, nxt);
        const char* nA = has_next ? (const char*)g.A + (size_t)nxt.pm * tstep : cA; const char* nB = has_next ? (const char*)g.Bt + (size_t)nxt.pn * tstep : cB;
        for (int t = 0; t < nt; t += 2) {
            const bool last = (t == nt - 2);
            const char* a1 = cA + (size_t)(t + 1) * kstep;
            const char* a2 = last ? nA : cA + (size_t)(t + 2) * kstep; const char* b2 = last ? nB : cB + (size_t)(t + 2) * kstep;
            const char* a3 = a2 + kstep; const char* b3 = b2 + kstep;
            if (last && has_next) S.a_ready(nxt);
            PG8_LDB(B0, 0, 0); PG8_SCHED; PG8_LDA(At, 0, 0); PG8_STAGE(PG8_SA(1, 1), a1 + hstep, voffA);
            PG8_WAIT_L(8); PG8_BAR; PG8_WAIT_L(0); PG8_MMA(0, 0, At, B0); PG8_BAR; PG8_SCHED;
            PG8_LDB(B1, 0, 1); PG8_STAGE(PG8_SB(0, 0), b2, voffB);
            PG8_BAR; PG8_WAIT_L(0); PG8_MMA(0, 1, At, B1); PG8_BAR;
            PG8_LDA(At, 0, 1); PG8_STAGE(PG8_SA(0, 0), a2, voffA);
            PG8_BAR; PG8_WAIT_L(0); PG8_MMA(1, 0, At, B0); PG8_BAR; PG8_SCHED;
            PG8_STAGE(PG8_SB(0, 1), b2 + hstep, voffB);
            PG8_WAIT_V(6); PG8_BAR; PG8_MMA(1, 1, At, B1); PG8_BAR;
            PG8_LDB(B0, 1, 0); PG8_SCHED; PG8_LDA(At, 1, 0); PG8_STAGE(PG8_SA(0, 1), a2 + hstep, voffA);
            PG8_WAIT_L(8); PG8_BAR; PG8_WAIT_L(0); PG8_MMA(0, 0, At, B0); PG8_BAR; PG8_SCHED;
            PG8_LDB(B1, 1, 1); PG8_STAGE(PG8_SB(1, 0), b3, voffB);
            PG8_BAR; PG8_WAIT_L(0); PG8_MMA(0, 1, At, B1); PG8_BAR;
            PG8_LDA(At, 1, 1); PG8_STAGE(PG8_SA(1, 0), a3, voffA);
            PG8_BAR; PG8_WAIT_L(0); PG8_MMA(1, 0, At, B0); PG8_BAR; PG8_SCHED;
            PG8_STAGE(PG8_SB(1, 1), b3 + hstep, voffB);
            PG8_WAIT_V(6); PG8_BAR; PG8_MMA(1, 1, At, B1); PG8_BAR;
        }
        PG8_STAMP();
        if constexpr (!Epi::AFTER_DRAIN) { E(acc, cur, wr, wc, fr, fq); S.done(cur); }
        PG8_STAMP();
        if (!has_next) break;
#pragma unroll
        for (int a = 0; a < 2; ++a)
#pragma unroll
            for (int b = 0; b < 2; ++b)
#pragma unroll
                for (int m = 0; m < 4; ++m)
#pragma unroll
                    for (int n = 0; n < 2; ++n) acc[a][b][m][n] = (f32x4){0.f, 0.f, 0.f, 0.f};
        cur = nxt; cA = nA; cB = nB; ++ui;
    }
    PG8_WAIT_V(0);
    if (wr == 0) PG8_BAR;
    PG8_BAR;
    if constexpr (Epi::AFTER_DRAIN) { E.fused(acc, cur, wr, wc, fr, fq, lds, wid, lane); S.done(cur); }
    PG8_STAMP();
    if (STAMP && wid == 0) { stamps[lane] = lane < nts ? (((unsigned long long)(unsigned)ts_hi << 32) | (unsigned)ts_lo) : 0ull;
        if (lane == 62) stamps[62] = rt_entry; if (lane == 63) stamps[63] = (unsigned long long)wall_clock64(); }
#undef PG8_STAMP
#undef PG8_SA
#undef PG8_SB
#undef PG8_STAGE
#undef PG8_LDA
#undef PG8_LDB
#undef PG8_MMA
#undef PG8_WAIT_V
#undef PG8_WAIT_L
#undef PG8_BAR
#undef PG8_SCHED
}
}

#include <hip/hip_cooperative_groups.h>
namespace cg = cooperative_groups;
using pg8::bf16_t; using pg8::f32x4; using pg8::bf16x8; using pg8::u32x4; using pg8::Unit;
#define LAS __attribute__((address_space(3)))
#define DI __device__ __forceinline__
typedef float f32x16 __attribute__((ext_vector_type(16)));
typedef float f32x2v __attribute__((ext_vector_type(2)));
typedef __bf16 bf16x2n __attribute__((ext_vector_type(2)));
typedef unsigned u32x2 __attribute__((ext_vector_type(2)));

constexpr int D = 1024, NBATCH = 8, SEQL = 4096, T = NBATCH * SEQL, CL = 256, TC = NBATCH * CL, TT = T + TC, FF = 2816, LK = SEQL + CL;
constexpr float EPS = 1e-6f;
constexpr size_t MiB = 1048576;
constexpr size_t WS_WFF_IN0 = 0, WS_WFF_IN1 = 11 * MiB, WS_WFF_OUT0 = 22 * MiB, WS_WFF_OUT1 = 22 * MiB + MiB * 11 / 2, WS_WA = 33 * MiB, WS_WB = 41 * MiB, WS_WG = 45 * MiB,
                 WS_WHY = 49 * MiB, WS_WDA = 51 * MiB, WS_WO = 53 * MiB, WS_MOD = 55 * MiB, WS_H3 = 55 * MiB + MiB / 2, WS_ROPE = 56 * MiB + MiB / 2, WS_BAR = 57 * MiB,
                 WS_XN = 58 * MiB, WS_ACT = 126 * MiB, WS_H = 313 * MiB, WS_ZT = 126 * MiB, WS_HYT = 382 * MiB, WS_Q = 126 * MiB, WS_K = 190 * MiB, WS_VT = 258 * MiB,
                 WS_HY = 446 * MiB, WS_BUFG = 254 * MiB, WS_MERGED = 382 * MiB, WS_Y = 190 * MiB, WS_GIMG = 446 * MiB, WS_END = 510 * MiB;
constexpr int IMGN = 16448, OFFO = 8226;
constexpr int LDS_BYTES = 131072 + 4096;

struct Params { const float* in[29]; float* out; unsigned char* ws; };

DI float bflo(unsigned w) { return __uint_as_float(w << 16); }
DI float bfhi(unsigned w) { return __uint_as_float(w & 0xffff0000u); }
DI float bf2f(unsigned short b) { return __uint_as_float(((unsigned)b) << 16); }
DI unsigned pk(float lo, float hi) { f32x2v v = {lo, hi}; bf16x2n b = __builtin_convertvector(v, bf16x2n); return __builtin_bit_cast(unsigned, b); }
DI unsigned short f2bf(float x) { return (unsigned short)(pk(x, 0.f) & 0xffffu); }
DI float shx(float v, int lane, int o) { return __int_as_float(__builtin_amdgcn_ds_bpermute((lane ^ o) << 2, __float_as_int(v))); }
DI float shl(float v, int src) { return __int_as_float(__builtin_amdgcn_ds_bpermute(src << 2, __float_as_int(v))); }
DI float wave_sum(float v, int lane) {
#pragma unroll
    for (int o = 32; o >= 1; o >>= 1) v += shx(v, lane, o);
    return v; }
DI float fast_exp2(float x) { return __builtin_amdgcn_exp2f(x); }
DI float siluf(float x) { return x * __builtin_amdgcn_rcpf(1.0f + __expf(-x)); }
DI float sigmf(float x) { return __builtin_amdgcn_rcpf(1.0f + __expf(-x)); }
DI int tid_opaque() { int t = threadIdx.x; asm volatile("" : "+v"(t)); return t; }
#define MFMA32(a, b, c) __builtin_amdgcn_mfma_f32_32x32x16_bf16((a), (b), (c), 0, 0, 0)

struct EpiSwiGLU {
    static constexpr bool PERM = true, AFTER_DRAIN = false;
    bf16_t* O;
    __device__ __forceinline__ void operator()(const f32x4 (&acc)[2][2][4][2], const Unit& u, int wr, int wc, int fr, int fq) const {
        const int row0 = u.pm * 256 + wr * 64 + fr, col0 = u.pn * 128 + wc * 32 + 8 * fq;
#pragma unroll
        for (int ai = 0; ai < 2; ++ai)
#pragma unroll
            for (int m = 0; m < 4; ++m) {
                bf16_t* rowp = O + (size_t)(row0 + ai * 128 + m * 16) * FF + col0;
                const f32x4 g0 = acc[ai][0][m][0], g1 = acc[ai][0][m][1], u0 = acc[ai][1][m][0], u1 = acc[ai][1][m][1];
                u32x4 w;
                w.x = pk(siluf(g0[0]) * u0[0], siluf(g0[1]) * u0[1]); w.y = pk(siluf(g0[2]) * u0[2], siluf(g0[3]) * u0[3]);
                w.z = pk(siluf(g1[0]) * u1[0], siluf(g1[1]) * u1[1]); w.w = pk(siluf(g1[2]) * u1[2], siluf(g1[3]) * u1[3]);
                *(u32x4*)rowp = w;
            }
    }
};
template <int MODE> struct EpiGen {
    static constexpr bool PERM = true, AFTER_DRAIN = false;
    bf16_t* O; long ldc; int rtpb; long rbstride; int rowoff; int ctpb; long cbstride; int coloff; const bf16_t* G; const float* rope; float scale; long ldg;
    __device__ __forceinline__ void operator()(const f32x4 (&acc)[2][2][4][2], const Unit& u, int wr, int wc, int fr, int fq) const {
        const long rbase = (long)(u.pm / rtpb) * rbstride + (long)(u.pm % rtpb) * 256 + rowoff;
        const long cboff = (long)(u.pn / ctpb) * cbstride;
        const int cbase = (u.pn % ctpb) * 256 + coloff;
#pragma unroll
        for (int ai = 0; ai < 2; ++ai)
#pragma unroll
            for (int m = 0; m < 4; ++m) {
                const int rl = ai * 128 + wr * 64 + m * 16 + fr;
                const long row = rbase + rl;
                f32x4 cs0 = {1.f, 0.f, 1.f, 0.f}, cs1 = {1.f, 0.f, 1.f, 0.f};
                if (MODE == 1) {
                    const int t = (u.pm & 15) * 256 + rl;
                    const int pos = (wc & 1) ? (t & 63) : (t >> 6);
                    const float* rp = rope + pos * 32 + 8 * fq;
                    cs0 = *(const f32x4*)rp; cs1 = *(const f32x4*)(rp + 4);
                }
#pragma unroll
                for (int bj = 0; bj < 2; ++bj) {
                    const int col = cbase + bj * 128 + wc * 32 + 8 * fq;
                    const size_t off = (size_t)cboff + (size_t)row * ldc + col;
                    f32x4 v0 = acc[ai][bj][m][0], v1 = acc[ai][bj][m][1];
                    if (MODE == 1) {
                        f32x4 a, b;
                        a[0] = v0[0] * cs0[0] - v0[1] * cs0[1]; a[1] = v0[0] * cs0[1] + v0[1] * cs0[0];
                        a[2] = v0[2] * cs0[2] - v0[3] * cs0[3]; a[3] = v0[2] * cs0[3] + v0[3] * cs0[2];
                        b[0] = v1[0] * cs1[0] - v1[1] * cs1[1]; b[1] = v1[0] * cs1[1] + v1[1] * cs1[0];
                        b[2] = v1[2] * cs1[2] - v1[3] * cs1[3]; b[3] = v1[2] * cs1[3] + v1[3] * cs1[2];
                        v0 = a * scale; v1 = b * scale;
                    }
                    if (MODE == 2) {
#pragma unroll
                        for (int j = 0; j < 4; ++j) { v0[j] = sigmf(v0[j]); v1[j] = sigmf(v1[j]); }
                    }
                    if (MODE == 3 || MODE == 4) {
                        const u32x4 g = *(const u32x4*)(G + (size_t)row * ldg + col);
                        v0[0] *= bflo(g.x); v0[1] *= bfhi(g.x); v0[2] *= bflo(g.y); v0[3] *= bfhi(g.y);
                        v1[0] *= bflo(g.z); v1[1] *= bfhi(g.z); v1[2] *= bflo(g.w); v1[3] *= bfhi(g.w);
                    }
                    if (MODE == 4) {
                        const u32x4 o = *(const u32x4*)(O + off);
                        v0[0] += bflo(o.x); v0[1] += bfhi(o.x); v0[2] += bflo(o.y); v0[3] += bfhi(o.y);
                        v1[0] += bflo(o.z); v1[1] += bfhi(o.z); v1[2] += bflo(o.w); v1[3] += bfhi(o.w);
                    }
                    u32x4 w; w.x = pk(v0[0], v0[1]); w.y = pk(v0[2], v0[3]); w.z = pk(v1[0], v1[1]); w.w = pk(v1[2], v1[3]);
                    if (MODE == 5) {
                        const int c16 = col & ~15, p0 = (col & 8) ? 4 : 0;
                        const size_t o2 = (size_t)cboff + (size_t)row * ldc + c16 + p0;
                        *(u32x2*)(O + o2) = (u32x2){w.x, w.y}; *(u32x2*)(O + o2 + 8) = (u32x2){w.z, w.w};
                    } else
                    *(u32x4*)(O + off) = w;
                }
            }
    }
};
struct EpiQK {
    static constexpr bool PERM = true, AFTER_DRAIN = false;
    EpiGen<1> q, k;
    __device__ __forceinline__ void operator()(const f32x4 (&acc)[2][2][4][2], const Unit& u, int wr, int wc, int fr, int fq) const {
        if (u.pn < 4) q(acc, u, wr, wc, fr, fq);
        else { Unit u2; u2.pm = u.pm; u2.pn = u.pn - 4; k(acc, u2, wr, wc, fr, fq); }
    }
};
template <int MODE> DI EpiGen<MODE> mk_epi(bf16_t* O, long ldc, const bf16_t* G = nullptr) {
    EpiGen<MODE> e; e.O = O; e.ldc = ldc; e.rtpb = 1 << 20; e.rbstride = 0; e.rowoff = 0; e.ctpb = 1 << 20; e.cbstride = 0; e.coloff = 0; e.G = G; e.rope = nullptr; e.scale = 1.f; e.ldg = ldc; return e; }

template <class Epi> DI void run_gemm(LAS unsigned char* lds, const bf16_t* A, const bf16_t* Bt, int M, int N, int K, const Epi& E, int crot = 0, int gsub = 0) {
    if (gsub > 0 && (int)blockIdx.x >= gsub) return;
    const int G = gsub > 0 ? gsub : (int)gridDim.x; const int c = ((int)blockIdx.x + G - crot) % G;
    pg8::Gemm g{A, Bt, M, N, K}; pg8::StaticOrder S; S.init(M, N, G, c);
    pg8::gemm_phase<Epi, pg8::StaticOrder, false>(lds, g, S, E, nullptr);
}

DI int colmap(int w, int n) {
    switch (w) {
        case 0: case 1: { const int pn = n >> 8, rr = n & 255; return rr < 128 ? pn * 128 + rr : FF + pn * 128 + (rr - 128); }
        case 4: return n < 3072 ? n : 5120 + (n - 3072);
        case 5: { const int base = n < 1024 ? 3072 : 4096; const int x = n & 1023; const int hm = x >> 6, pp = x & 63; const int pi = pp >> 1, half = pp & 1, axis = pi >> 4, f = pi & 15;
                  return base + hm * 64 + axis * 32 + half * 16 + f; }
        case 6: return 6144 + n;
        default: return n;
    }
}
__device__ __forceinline__ void convert_tiles(const Params& p, unsigned char* shm, int v_first, int v_step, int v_end, int mode) {
    float* tile = (float*)shm;
    const int tid = tid_opaque();
    for (int v = v_first; v < v_end; v += v_step) {
        const int ti = mode == 1 ? 1408 + v : mode == 2 ? (v < 704 ? 3520 + v : 6784 + (v - 704)) : mode == 3 ? 5760 + v
                     : (v < 1408 ? v : (v < 2112 ? v + 1408 : (v < 3648 ? v + 2112 : v + 2624)));
        int w, loc;
        if (ti < 1408) { w = 0; loc = ti; } else if (ti < 2816) { w = 1; loc = ti - 1408; } else if (ti < 3520) { w = 2; loc = ti - 2816; } else if (ti < 4224) { w = 3; loc = ti - 3520; }
        else if (ti < 5248) { w = 4; loc = ti - 4224; } else if (ti < 5760) { w = 5; loc = ti - 5248; } else if (ti < 6272) { w = 6; loc = ti - 5760; }
        else if (ti < 6528) { w = 7; loc = ti - 6272; } else if (ti < 6784) { w = 8; loc = ti - 6528; } else { w = 9; loc = ti - 6784; }
        const float* src; int ld, K; size_t dsto;
        if (w == 0) { src = p.in[7]; ld = 2 * FF; K = 1024; dsto = WS_WFF_IN0; }
        else if (w == 1) { src = p.in[7] + (size_t)1024 * 2 * FF; ld = 2 * FF; K = 1024; dsto = WS_WFF_IN1; }
        else if (w == 2) { src = p.in[8]; ld = 1024; K = FF; dsto = WS_WFF_OUT0; }
        else if (w == 3) { src = p.in[8] + (size_t)FF * 1024; ld = 1024; K = FF; dsto = WS_WFF_OUT1; }
        else if (w == 4) { src = p.in[9]; ld = 8192; K = 1024; dsto = WS_WA; }
        else if (w == 5) { src = p.in[9]; ld = 8192; K = 1024; dsto = WS_WB; }
        else if (w == 6) { src = p.in[9]; ld = 8192; K = 1024; dsto = WS_WG; }
        else if (w == 7) { src = p.in[26]; ld = 1024; K = 1024; dsto = WS_WHY; }
        else if (w == 8) { src = p.in[27]; ld = 1024; K = 1024; dsto = WS_WDA; }
        else { src = p.in[28]; ld = 1024; K = 1024; dsto = WS_WO; }
        bf16_t* dst = (bf16_t*)(p.ws + dsto);
        const int kT = K >> 6, kt = loc % kT, nt = loc / kT, k0 = kt * 64, n0 = nt * 64;
        {
            const int nl = tid & 63, kq = tid >> 6; const int sc = colmap(w, n0 + nl);
#pragma unroll
            for (int i = 0; i < 8; ++i) { const int kl = kq + 8 * i; tile[kl * 65 + nl] = src[(size_t)(k0 + kl) * ld + sc]; }
        }
        __syncthreads();
        {
            const int nl = tid >> 3, kc = (tid & 7) * 8;
            u32x4 wv; float v[8];
#pragma unroll
            for (int j = 0; j < 8; ++j) v[j] = tile[(kc + j) * 65 + nl];
            wv.x = pk(v[0], v[1]); wv.y = pk(v[2], v[3]); wv.z = pk(v[4], v[5]); wv.w = pk(v[6], v[7]);
            *(u32x4*)(dst + (size_t)(n0 + nl) * K + k0 + kc) = wv;
        }
        __syncthreads();
    }
}
__device__ __forceinline__ void p0_adaln(const Params& p, unsigned char* shm) {
    if (blockIdx.x >= 144) return;
    float* ssil = (float*)shm;
    float* red = ssil + 9 * 1024;
    const int tid = tid_opaque();
    const float* c = p.in[1]; const float* cctx = p.in[3]; const float* wada = p.in[4]; const float* bada = p.in[5];
    float* MOD = (float*)(p.ws + WS_MOD);
    for (int i = tid; i < 9216; i += 512) { const int b = i >> 10, k = i & 1023; const float v = b < 8 ? c[b * 1024 + k] : cctx[k]; ssil[i] = siluf(v); }
    __syncthreads();
    for (int u = blockIdx.x; u < 144; u += gridDim.x) {
        const int jl = tid & 63, kg = tid >> 6, j = u * 64 + jl;
        float a[9];
#pragma unroll
        for (int b = 0; b < 9; ++b) a[b] = 0.f;
        for (int k = kg * 128; k < kg * 128 + 128; ++k) {
            const float wv = wada[(size_t)k * 9216 + j];
#pragma unroll
            for (int b = 0; b < 9; ++b) a[b] += ssil[b * 1024 + k] * wv;
        }
#pragma unroll
        for (int b = 0; b < 9; ++b) red[(kg * 9 + b) * 64 + jl] = a[b];
        __syncthreads();
        for (int i = tid; i < 576; i += 512) {
            const int b = i >> 6, j2 = i & 63; float s = 0.f;
#pragma unroll
            for (int g = 0; g < 8; ++g) s += red[(g * 9 + b) * 64 + j2];
            MOD[b * 9216 + u * 64 + j2] = s + bada[u * 64 + j2];
        }
        __syncthreads();
    }
}
__device__ __forceinline__ void p0_h3(const Params& p) {
    const int tid = tid_opaque(); const int lane = tid & 63, wave = tid >> 6;
    const float* w1 = p.in[12]; const float* b1 = p.in[13]; const float* w2 = p.in[14]; const float* b2 = p.in[15]; const float* w3 = p.in[16]; const float* b3 = p.in[17]; const float* freq = p.in[19];
    float* H3 = (float*)(p.ws + WS_H3);
    const float fr = freq[lane];
    for (int t = blockIdx.x * 8 + wave; t < SEQL; t += gridDim.x * 8) {
        const float tl = (float)t / 4095.0f;
        const float w = 6.283185307179586f * (float)t / 4096.0f;
        float z = 0.f;
        if (lane == 0) z = tl;
        else if (lane <= 16) { const float f = 1e-4f + (float)(lane - 1) * ((15.0f - 1e-4f) / 15.0f); z = cosf(f * w); }
        else if (lane <= 32) { const float f = 1e-4f + (float)(lane - 17) * ((15.0f - 1e-4f) / 15.0f); z = -sinf(f * w); }
        float h = b1[lane];
        for (int i = 0; i < 33; ++i) h += shl(z, i) * w1[i * 64 + lane];
        h = sinf(fr * h);
        float h2 = b2[lane];
        for (int i = 0; i < 64; ++i) h2 += shl(h, i) * w2[i * 64 + lane];
        h2 = sinf(fr * h2);
        float h3 = b3[lane];
        for (int i = 0; i < 64; ++i) h3 += shl(h2, i) * w3[i * 64 + lane];
        h3 = sinf(fr * h3);
        H3[t * 64 + lane] = h3;
    }
    if (blockIdx.x == gridDim.x - 1) {
        float* ROPE = (float*)(p.ws + WS_ROPE);
        for (int idx = tid; idx < 1024; idx += 512) {
            const int pos = idx >> 4, f = idx & 15;
            const float inv = powf(10000.0f, -(float)(2 * f) / 32.0f);
            const float ang = (float)pos * inv;
            ROPE[idx * 2] = cosf(ang); ROPE[idx * 2 + 1] = sinf(ang);
        }
    }
}
__device__ __forceinline__ void p1_filter(const Params& p, unsigned char* shm) {
    float* vals = (float*)shm;
    float* w4s = (float*)(shm + 131072);
    float* red = w4s + 512;
    const int tid = tid_opaque(), lane = tid & 63, wave = tid >> 6;
    const float* w4 = p.in[18]; const float* H3 = (const float*)(p.ws + WS_H3);
    unsigned short* GIMG = (unsigned short*)(p.ws + WS_GIMG);
    for (int u = blockIdx.x; u < 256; u += gridDim.x) {
        const int c0 = u * 4;
        { const int ii = tid >> 3, q = tid & 7, cc = q >> 1, dir = q & 1; w4s[tid] = w4[(size_t)ii * 2048 + dir * 1024 + c0 + cc]; }
        __syncthreads();
        float sums[4] = {0.f, 0.f, 0.f, 0.f};
#pragma unroll 1
        for (int it = 0; it < 8; ++it) {
            const int t = tid + 512 * it;
            float a[8];
#pragma unroll
            for (int q = 0; q < 8; ++q) a[q] = 0.f;
            const f32x4* hp = (const f32x4*)(H3 + (size_t)t * 64);
#pragma unroll 2
            for (int i4 = 0; i4 < 16; ++i4) {
                const f32x4 hv = hp[i4];
#pragma unroll
                for (int e = 0; e < 4; ++e) {
                    const float* wr = w4s + (i4 * 4 + e) * 8;
#pragma unroll
                    for (int q = 0; q < 8; ++q) a[q] += hv[e] * wr[q];
                }
            }
            const float tl = (float)t / 4095.0f;
#pragma unroll
            for (int cc = 0; cc < 4; ++cc) {
                const float delta = 3.0701134573f + (float)(c0 + cc) * ((15.3505672866f - 3.0701134573f) / 1023.0f);
                const float dec = expf(-tl * delta);
                const float f = a[cc * 2] * dec, bwd = a[cc * 2 + 1] * dec;
                vals[t * 8 + cc * 2] = f; vals[t * 8 + cc * 2 + 1] = bwd;
                sums[cc] += fabsf(f) + (t >= 1 ? fabsf(bwd) : 0.f);
            }
        }
#pragma unroll
        for (int cc = 0; cc < 4; ++cc) { const float s = wave_sum(sums[cc], lane); if (lane == 0) red[wave * 4 + cc] = s; }
        __syncthreads();
        float inv[4];
#pragma unroll
        for (int cc = 0; cc < 4; ++cc) { float s = 0.f;
#pragma unroll
            for (int g = 0; g < 8; ++g) s += red[g * 4 + cc];
            inv[cc] = 1.0f / (s + EPS); }
#pragma unroll 1
        for (int it = 0; it < 8; ++it) {
            const int t = tid + 512 * it;
#pragma unroll
            for (int cc = 0; cc < 4; ++cc) {
                unsigned short* img = GIMG + (size_t)(c0 + cc) * IMGN;
                const unsigned short f = f2bf(vals[t * 8 + cc * 2] * inv[cc]), bb = f2bf(vals[t * 8 + cc * 2 + 1] * inv[cc]);
                const int pf = SEQL - t;
                img[pf] = f; img[OFFO + pf - 1] = f;
                if (t >= 1) { const int pb = SEQL + t; img[pb] = bb; img[OFFO + pb - 1] = bb; }
                else { img[0] = 0; img[OFFO + 8191] = 0; }
            }
        }
        __syncthreads();
    }
}
template <bool HAS_SRC, int RES_IN, int RES_OUT, bool WRITE_XN>
__device__ __forceinline__ void row_phase(const Params& p, const bf16_t* SRC, const void* res_lat, const float* res_ctx, void* RES_OUT_P, bf16_t* XN, int nrows,
                          const float* g_post, float gmul, int gate_idx, const float* g_pre, int shift_idx, int scale_idx, int row_begin = 0, int bfirst = 0) {
    const int tid = tid_opaque(); const int lane = tid & 63, wave = tid >> 6;
    const float* MOD = (const float*)(p.ws + WS_MOD);
    if ((int)blockIdx.x < bfirst) return;
    for (int row = row_begin + ((int)blockIdx.x - bfirst) * 8 + wave; row < nrows; row += ((int)gridDim.x - bfirst) * 8) {
        const int b = row < T ? row / SEQL : 8;
        const float* mod = MOD + b * 9216;
        f32x4 v[4];
        if (RES_IN == 1) {
            const bf16_t* rin = (const bf16_t*)res_lat + (size_t)row * D;
#pragma unroll
            for (int i = 0; i < 4; ++i) { const u32x2 w = *(const u32x2*)(rin + (i * 64 + lane) * 4); v[i][0] = bflo(w.x); v[i][1] = bfhi(w.x); v[i][2] = bflo(w.y); v[i][3] = bfhi(w.y); }
        } else {
            const float* rin = row < T ? (const float*)res_lat + (size_t)row * D : res_ctx + (size_t)(row - T) * D;
#pragma unroll
            for (int i = 0; i < 4; ++i) v[i] = *(const f32x4*)(rin + (i * 64 + lane) * 4);
        }
        if (HAS_SRC) {
            f32x4 hsrc[4]; float ss = 0.f;
#pragma unroll
            for (int i = 0; i < 4; ++i) {
                const u32x2 w = *(const u32x2*)(SRC + (size_t)row * D + (i * 64 + lane) * 4);
                hsrc[i][0] = bflo(w.x); hsrc[i][1] = bfhi(w.x); hsrc[i][2] = bflo(w.y); hsrc[i][3] = bfhi(w.y);
                ss += hsrc[i][0] * hsrc[i][0] + hsrc[i][1] * hsrc[i][1] + hsrc[i][2] * hsrc[i][2] + hsrc[i][3] * hsrc[i][3];
            }
            ss = wave_sum(ss, lane);
            const float rstd = rsqrtf(ss * (1.0f / D) + EPS);
#pragma unroll
            for (int i = 0; i < 4; ++i) {
                const int col = (i * 64 + lane) * 4;
                const f32x4 gp = *(const f32x4*)(g_post + col), gt = *(const f32x4*)(mod + gate_idx * 1024 + col);
                v[i] += gmul * gt * (hsrc[i] * rstd * gp);
            }
        }
        if (RES_OUT == 1 && row < T) {
#pragma unroll
            for (int i = 0; i < 4; ++i) *(f32x4*)((float*)RES_OUT_P + (size_t)row * D + (i * 64 + lane) * 4) = v[i];
        }
        if (RES_OUT == 2 && row < T) {
#pragma unroll
            for (int i = 0; i < 4; ++i) { u32x2 w; w.x = pk(v[i][0], v[i][1]); w.y = pk(v[i][2], v[i][3]); *(u32x2*)((bf16_t*)RES_OUT_P + (size_t)row * D + (i * 64 + lane) * 4) = w; }
        }
        if (WRITE_XN) {
            float ss = 0.f;
#pragma unroll
            for (int i = 0; i < 4; ++i) ss += v[i][0] * v[i][0] + v[i][1] * v[i][1] + v[i][2] * v[i][2] + v[i][3] * v[i][3];
            ss = wave_sum(ss, lane);
            const float rstd = rsqrtf(ss * (1.0f / D) + EPS);
#pragma unroll
            for (int i = 0; i < 4; ++i) {
                const int col = (i * 64 + lane) * 4;
                const f32x4 gp = *(const f32x4*)(g_pre + col), sh = *(const f32x4*)(mod + shift_idx * 1024 + col), sc = *(const f32x4*)(mod + scale_idx * 1024 + col);
                const f32x4 y = (v[i] * rstd * gp) * (1.0f + sc) + sh;
                u32x2 w; w.x = pk(y[0], y[1]); w.y = pk(y[2], y[3]);
                *(u32x2*)(XN + (size_t)row * D + col) = w;
            }
        }
    }
}
DI void conv8(const bf16_t* prow, int t0, float w0, float w1, float w2, float bias, float (&out)[8]) {
    const u32x4 a = *(const u32x4*)(prow + t0);
    float x[10];
    x[0] = t0 > 0 ? bf2f(prow[t0 - 1]) : 0.f; x[9] = t0 + 8 < SEQL ? bf2f(prow[t0 + 8]) : 0.f;
    x[1] = bflo(a.x); x[2] = bfhi(a.x); x[3] = bflo(a.y); x[4] = bfhi(a.y); x[5] = bflo(a.z); x[6] = bfhi(a.z); x[7] = bflo(a.w); x[8] = bfhi(a.w);
#pragma unroll
    for (int j = 0; j < 8; ++j) out[j] = w0 * x[j] + w1 * x[j + 1] + w2 * x[j + 2] + bias;
}
__device__ __forceinline__ void hyena_phase(const Params& p, LAS unsigned char* lds) {
    const int tid = tid_opaque(), lane = tid & 63, wave = __builtin_amdgcn_readfirstlane(tid >> 6), r = lane & 31, h = lane >> 5;
    const bf16_t* ZT = (const bf16_t*)(p.ws + WS_ZT); const unsigned short* GIMG = (const unsigned short*)(p.ws + WS_GIMG); bf16_t* HYT = (bf16_t*)(p.ws + WS_HYT);
    const float* cw = p.in[10]; const float* cb = p.in[11]; const float* hyb = p.in[20];
    constexpr int UROW = 8768, IOFF = 70144, ZOFF = 103424;
    if (tid < 32) *(LAS u32x4*)(lds + ZOFF + tid * 16) = (u32x4){0u, 0u, 0u, 0u};
    const int cb_ = r >> 2, ctb = 4 * wave + (r & 3);
    const int dlo = (4 * wave - 31) > -31 ? (4 * wave - 31) : -31, dhi = (4 * wave + 3) < 31 ? (4 * wave + 3) : 31;
    for (int c = blockIdx.x; c < 1024; c += gridDim.x) {
        { const u32x4* src = (const u32x4*)(GIMG + (size_t)c * IMGN); for (int i = tid; i < IMGN / 8; i += 512) *(LAS u32x4*)(lds + IOFF + i * 16) = src[i]; }
        {
            const float wx0 = cw[1024 + c], wx1 = cw[3072 + 1024 + c], wx2 = cw[6144 + 1024 + c], bx = cb[1024 + c];
            const float wv0 = cw[2048 + c], wv1 = cw[3072 + 2048 + c], wv2 = cw[6144 + 2048 + c], bv = cb[2048 + c];
#pragma unroll 2
            for (int it = 0; it < 8; ++it) {
                const int idx8 = it * 512 + tid, b = idx8 >> 9, t0 = (idx8 & 511) * 8;
                float x1c[8], vc[8];
                conv8(ZT + (size_t)(1024 + c) * T + b * SEQL, t0, wx0, wx1, wx2, bx, x1c);
                conv8(ZT + (size_t)(2048 + c) * T + b * SEQL, t0, wv0, wv1, wv2, bv, vc);
                u32x4 w; w.x = pk(vc[0] * x1c[0], vc[1] * x1c[1]); w.y = pk(vc[2] * x1c[2], vc[3] * x1c[3]); w.z = pk(vc[4] * x1c[4], vc[5] * x1c[5]); w.w = pk(vc[6] * x1c[6], vc[7] * x1c[7]);
                *(LAS u32x4*)(lds + b * UROW + (t0 >> 7) * 272 + (t0 & 127) * 2) = w;
            }
        }
        __syncthreads();
        f32x16 acc[4];
#pragma unroll
        for (int mi = 0; mi < 4; ++mi)
#pragma unroll
            for (int i = 0; i < 16; ++i) acc[mi][i] = 0.f;
        const LAS unsigned* img32 = (const LAS unsigned*)(lds + IOFF);
        const int wl = ((r & 1) ? (OFFO / 2) : 0) + ((SEQL - r + 8 * h - (r & 1)) >> 1);
        bf16x8 A[14], Bc[8];
        {
            const LAS unsigned* ab = img32 + (wl - 64 * dlo);
#pragma unroll
            for (int o = 0; o < 14; ++o) { const LAS unsigned* q = ab - 8 * (o - 7); u32x4 w; w.x = q[0]; w.y = q[1]; w.z = q[2]; w.w = q[3]; A[o] = __builtin_bit_cast(bf16x8, w); }
            const int sb = ctb - dlo; const bool valid = (unsigned)sb < 32u;
            const LAS unsigned char* ub = lds + (valid ? cb_ * UROW + sb * 272 : ZOFF) + h * 16;
#pragma unroll
            for (int ks = 0; ks < 8; ++ks) Bc[ks] = *(const LAS bf16x8*)(ub + ks * 32);
        }
#pragma unroll 1
        for (int db = dlo; db <= dhi; ++db) {
            bf16x8 An[8], Bn[8];
            {
                const int dn = db < dhi ? db + 1 : dhi;
                const LAS unsigned* ab = img32 + (wl - 64 * dn);
#pragma unroll
                for (int j = 0; j < 8; ++j) { const LAS unsigned* q = ab - 8 * (j - 1); u32x4 w; w.x = q[0]; w.y = q[1]; w.z = q[2]; w.w = q[3]; An[j] = __builtin_bit_cast(bf16x8, w); }
                const int sb = ctb - dn; const bool valid = (unsigned)sb < 32u;
                const LAS unsigned char* ub = lds + (valid ? cb_ * UROW + sb * 272 : ZOFF) + h * 16;
#pragma unroll
                for (int ks = 0; ks < 8; ++ks) Bn[ks] = *(const LAS bf16x8*)(ub + ks * 32);
            }
            __builtin_amdgcn_sched_barrier(0);
#pragma unroll
            for (int ks = 0; ks < 8; ++ks)
#pragma unroll
                for (int mi = 0; mi < 4; ++mi) acc[mi] = MFMA32(A[2 * mi - ks + 7], Bc[ks], acc[mi]);
            __builtin_amdgcn_sched_barrier(0);
#pragma unroll
            for (int o = 0; o < 6; ++o) A[o] = A[o + 8];
#pragma unroll
            for (int j = 0; j < 8; ++j) { A[6 + j] = An[j]; Bc[j] = Bn[j]; }
        }
        __syncthreads();
        {
            const float hb = hyb[c];
#pragma unroll
            for (int mi = 0; mi < 4; ++mi)
#pragma unroll
                for (int g4 = 0; g4 < 4; ++g4) {
                    const int i0 = 32 * mi + 8 * g4 + 4 * h;
                    LAS unsigned* up = (LAS unsigned*)(lds + cb_ * UROW + ctb * 272 + i0 * 2);
                    const unsigned w0 = up[0], w1 = up[1];
                    const float y0 = acc[mi][4 * g4 + 0] + bflo(w0) * hb, y1 = acc[mi][4 * g4 + 1] + bfhi(w0) * hb, y2 = acc[mi][4 * g4 + 2] + bflo(w1) * hb, y3 = acc[mi][4 * g4 + 3] + bfhi(w1) * hb;
                    up[0] = pk(y0, y1); up[1] = pk(y2, y3);
                }
        }
        __syncthreads();
        {
            const float w0 = cw[c], w1 = cw[3072 + c], w2 = cw[6144 + c], bb = cb[c];
#pragma unroll 2
            for (int it = 0; it < 8; ++it) {
                const int idx8 = it * 512 + tid, b = idx8 >> 9, t0 = (idx8 & 511) * 8;
                float x0c[8];
                conv8(ZT + (size_t)c * T + b * SEQL, t0, w0, w1, w2, bb, x0c);
                const u32x4 y = *(const LAS u32x4*)(lds + b * UROW + (t0 >> 7) * 272 + (t0 & 127) * 2);
                u32x4 w; w.x = pk(bflo(y.x) * x0c[0], bfhi(y.x) * x0c[1]); w.y = pk(bflo(y.y) * x0c[2], bfhi(y.y) * x0c[3]);
                w.z = pk(bflo(y.z) * x0c[4], bfhi(y.z) * x0c[5]); w.w = pk(bflo(y.w) * x0c[6], bfhi(y.w) * x0c[7]);
                *(u32x4*)(HYT + (size_t)c * T + b * SEQL + t0) = w;
            }
        }
        __syncthreads();
    }
}
__device__ __forceinline__ void transpose_phase(const Params& p, unsigned char* shm) {
    unsigned short* tile = (unsigned short*)shm;
    const bf16_t* HYT = (const bf16_t*)(p.ws + WS_HYT); bf16_t* HY = (bf16_t*)(p.ws + WS_HY);
    const int tid = tid_opaque();
    for (int ti = blockIdx.x; ti < 16 * 512; ti += gridDim.x) {
        const int ct = ti & 15, tt = ti >> 4, c0 = ct * 64, t0 = tt * 64;
        { const int cl = tid >> 3, ch = tid & 7; const u32x4 v = *(const u32x4*)(HYT + (size_t)(c0 + cl) * T + t0 + ch * 8); *(u32x4*)(tile + cl * 72 + ch * 8) = v; }
        __syncthreads();
        { const int tl = tid >> 3, cc = (tid & 7) * 8; unsigned short e[8];
#pragma unroll
          for (int j = 0; j < 8; ++j) e[j] = tile[(cc + j) * 72 + tl];
          u32x4 w; w.x = e[0] | ((unsigned)e[1] << 16); w.y = e[2] | ((unsigned)e[3] << 16); w.z = e[4] | ((unsigned)e[5] << 16); w.w = e[6] | ((unsigned)e[7] << 16);
          *(u32x4*)(HY + (size_t)(t0 + tl) * D + c0 + cc) = w; }
        __syncthreads();
    }
}
DI bf16x8 pack8(const f32x16& s, int base) {
    u32x4 w; w.x = pk(s[base + 0], s[base + 1]); w.y = pk(s[base + 2], s[base + 3]); w.z = pk(s[base + 4], s[base + 5]); w.w = pk(s[base + 6], s[base + 7]);
    return __builtin_bit_cast(bf16x8, w);
}
typedef float f32x8 __attribute__((ext_vector_type(8)));
constexpr int AT_VOFF = 16384, AT_BUFSZ = 32768, AT_OOFF = 67584, AT_NKT = LK / 64;
DI void attn_pv(const LAS unsigned char* buf, const int (&voff)[4], const bf16x8 (&pf)[4], f32x16 (&o)[4]) {
#pragma unroll
    for (int s4 = 0; s4 < 4; ++s4) {
#pragma unroll
        for (int mt = 0; mt < 4; ++mt) {
            const bf16x8 vf = *(const LAS bf16x8*)(buf + voff[s4] + mt * 4096);
            o[mt] = MFMA32(vf, pf[s4], o[mt]);
        }
    }
}
__device__ __forceinline__ void attn_phase(const Params& p, LAS unsigned char* lds, bf16_t* OUTP) {
    const int tid = tid_opaque(), lane = tid & 63, wave = __builtin_amdgcn_readfirstlane(tid >> 6), r = lane & 31, h = lane >> 5, map = wave >> 2, qw = wave & 3;
    float lam;
    { float a1 = p.in[21][lane] * p.in[22][lane], a2 = p.in[23][lane] * p.in[24][lane]; a1 = wave_sum(a1, lane); a2 = wave_sum(a2, lane); lam = expf(a1) - expf(a2) + 0.2f; }
    const bf16_t* Q = (const bf16_t*)(p.ws + WS_Q); const bf16_t* K = (const bf16_t*)(p.ws + WS_K); const bf16_t* VT = (const bf16_t*)(p.ws + WS_VT);
    const float* subg = p.in[25];
    const int G = gridDim.x, bx = blockIdx.x;
    const int vcu = (G % 8 == 0) ? (bx % 8) * (G / 8) + bx / 8 : bx;
    int koff[4], voff[4];
#pragma unroll
    for (int ks = 0; ks < 4; ++ks) koff[ks] = r * 256 + ((((map * 8 + 2 * ks + h) ^ (r & 15))) << 4);
#pragma unroll
    for (int s4 = 0; s4 < 4; ++s4) voff[s4] = AT_VOFF + r * 128 + ((((2 * s4 + h) ^ ((r >> 1) & 7))) << 4);
    int ksrc[2], vsrc[2];
#pragma unroll
    for (int i = 0; i < 2; ++i) {
        const int j = 2 * wave + i;
        const int krow = 4 * j + (lane >> 4), kc = (lane & 15) ^ (krow & 15);
        ksrc[i] = krow * D + kc * 8;
        const int ve = 8 * j + (lane >> 3), vc = (lane & 7) ^ ((ve >> 1) & 7);
        vsrc[i] = ve * LK + vc * 8;
    }
    for (int i = tid; i < 16384 / 16; i += 512) *(LAS u32x4*)(lds + 2 * AT_BUFSZ + AT_VOFF + i * 16) = (u32x4){0u, 0u, 0u, 0u};
    __syncthreads();
#define AT_DMA(slot, kt_) do { \
        LAS unsigned char* _d = lds + (slot) * AT_BUFSZ + wave * 2048; \
        const bf16_t* _k = kg + (size_t)(kt_) * 64 * D; const bf16_t* _v = vg + (kt_) * 64; \
        __builtin_amdgcn_global_load_lds((const unsigned*)(_k + ksrc[0]), (LAS unsigned*)(_d), 16, 0, 0); \
        __builtin_amdgcn_global_load_lds((const unsigned*)(_k + ksrc[1]), (LAS unsigned*)(_d + 1024), 16, 0, 0); \
        __builtin_amdgcn_global_load_lds((const unsigned*)(_v + vsrc[0]), (LAS unsigned*)(_d + AT_VOFF), 16, 0, 0); \
        __builtin_amdgcn_global_load_lds((const unsigned*)(_v + vsrc[1]), (LAS unsigned*)(_d + AT_VOFF + 1024), 16, 0, 0); } while (0)
    for (int u = vcu; u < 2048; u += G) {
        const int b = u >> 8, hd = (u >> 5) & 7, qb = u & 31;
        const bf16_t* qp = Q + ((size_t)(b * SEQL + qb * 128 + qw * 32 + r)) * D + hd * 128 + map * 64 + 8 * h;
        bf16x8 qf[4];
#pragma unroll
        for (int ks = 0; ks < 4; ++ks) qf[ks] = *(const bf16x8*)(qp + 16 * ks);
        const bf16_t* kg = K + (size_t)b * LK * D + hd * 128;
        const bf16_t* vg = VT + ((size_t)b * D + hd * 128) * LK;
        AT_DMA(0, 0);
        asm volatile("s_waitcnt vmcnt(0)" ::: "memory");
        __syncthreads();
        float l_run = 0.f;
        f32x16 o[4], negm;
#pragma unroll
        for (int i = 0; i < 16; ++i) negm[i] = 0.f;
#pragma unroll
        for (int mt = 0; mt < 4; ++mt)
#pragma unroll
            for (int i = 0; i < 16; ++i) o[mt][i] = 0.f;
        bf16x8 pf[4];
#pragma unroll
        for (int i = 0; i < 4; ++i) pf[i] = (bf16x8){0, 0, 0, 0, 0, 0, 0, 0};
        int bcur = 0, bprev = 2;
        for (int kt = 0; kt < AT_NKT; ++kt) {
            const LAS unsigned char* cur = lds + bcur * AT_BUFSZ;
            const int bnext = (bcur == 2) ? 0 : bcur + 1;
            const bool more = kt + 1 < AT_NKT;
            if (more) AT_DMA(bnext, kt + 1);
            f32x16 s0 = negm, s1 = negm;
#pragma unroll
            for (int ks = 0; ks < 4; ++ks) {
                const bf16x8 kf0 = *(const LAS bf16x8*)(cur + koff[ks]);
                const bf16x8 kf1 = *(const LAS bf16x8*)(cur + koff[ks] + 8192);
                s0 = MFMA32(kf0, qf[ks], s0); s1 = MFMA32(kf1, qf[ks], s1);
            }
            __builtin_amdgcn_sched_barrier(0);
            float mx = fmaxf(fmaxf(s0[0], s0[1]), s0[2]);
#pragma unroll
            for (int i = 3; i < 15; i += 2) mx = fmaxf(fmaxf(mx, s0[i]), s0[i + 1]);
            mx = fmaxf(fmaxf(mx, s0[15]), s1[0]);
#pragma unroll
            for (int i = 1; i < 15; i += 2) mx = fmaxf(fmaxf(mx, s1[i]), s1[i + 1]);
            mx = fmaxf(mx, s1[15]);
            const bool need = (kt == 0) || (__builtin_amdgcn_ballot_w64(mx > 8.0f) != 0ull);
            float alpha = 1.0f;
            if (need) {
                const float mxp = fmaxf(mx, shx(mx, lane, 32));
                const float delta = (kt == 0) ? mxp : fmaxf(mxp, 0.f);
                alpha = fast_exp2(-delta);
                s0 = s0 - delta; s1 = s1 - delta; negm = negm - delta;
                l_run *= alpha;
            }
            __builtin_amdgcn_sched_barrier(0);
            attn_pv(lds + bprev * AT_BUFSZ, voff, pf, o);
#pragma unroll
            for (int i = 0; i < 16; ++i) { s0[i] = fast_exp2(s0[i]); s1[i] = fast_exp2(s1[i]); }
            {
                const f32x16 t16 = s0 + s1; const f32x8 t8 = t16.lo + t16.hi; const f32x4 t4 = t8.lo + t8.hi;
                l_run += (t4[0] + t4[1]) + (t4[2] + t4[3]);
            }
            bf16x8 pn[4];
            pn[0] = pack8(s0, 0); pn[1] = pack8(s0, 8); pn[2] = pack8(s1, 0); pn[3] = pack8(s1, 8);
#pragma unroll
            for (int i = 0; i < 16; ++i) { __builtin_amdgcn_sched_group_barrier(0x008, 1, 0); __builtin_amdgcn_sched_group_barrier(0x100, 1, 0); __builtin_amdgcn_sched_group_barrier(0x002, 5, 0); }
            __builtin_amdgcn_sched_barrier(0);
            if (need) {
#pragma unroll
                for (int mt = 0; mt < 4; ++mt) o[mt] *= alpha;
            }
#pragma unroll
            for (int i = 0; i < 4; ++i) pf[i] = pn[i];
            asm volatile("s_waitcnt vmcnt(0)" ::: "memory");
            __syncthreads();
            bprev = bcur; bcur = bnext;
        }
        attn_pv(lds + bprev * AT_BUFSZ, voff, pf, o);
        __syncthreads();
        const float ltot = l_run + shx(l_run, lane, 32);
        const float invl = 1.0f / ltot;
        const int ql = qw * 32 + r;
        if (map == 1) {
            const float sc = invl * lam;
#pragma unroll
            for (int mt = 0; mt < 4; ++mt)
#pragma unroll
                for (int g4 = 0; g4 < 4; ++g4) {
                    const int e0 = 32 * mt + 8 * g4 + 4 * h;
                    f32x4 w; w[0] = o[mt][4 * g4] * sc; w[1] = o[mt][4 * g4 + 1] * sc; w[2] = o[mt][4 * g4 + 2] * sc; w[3] = o[mt][4 * g4 + 3] * sc;
                    *(LAS f32x4*)(lds + (ql * 132 + e0) * 4) = w;
                }
        }
        __syncthreads();
        if (map == 0) {
            float ss = 0.f;
#pragma unroll
            for (int mt = 0; mt < 4; ++mt)
#pragma unroll
                for (int g4 = 0; g4 < 4; ++g4) {
                    const int e0 = 32 * mt + 8 * g4 + 4 * h;
                    const f32x4 w = *(const LAS f32x4*)(lds + (ql * 132 + e0) * 4);
#pragma unroll
                    for (int j = 0; j < 4; ++j) { const float v = o[mt][4 * g4 + j] * invl - w[j]; o[mt][4 * g4 + j] = v; ss += v * v; }
                }
            ss += shx(ss, lane, 32);
            const float rstd = rsqrtf(ss * (1.0f / 128.0f) + EPS) * 0.8f;
#pragma unroll
            for (int mt = 0; mt < 4; ++mt)
#pragma unroll
                for (int g4 = 0; g4 < 4; ++g4) {
                    const int e0 = 32 * mt + 8 * g4 + 4 * h;
                    const f32x4 sg = *(const f32x4*)(subg + e0);
                    u32x2 w; w.x = pk(o[mt][4 * g4] * rstd * sg[0], o[mt][4 * g4 + 1] * rstd * sg[1]); w.y = pk(o[mt][4 * g4 + 2] * rstd * sg[2], o[mt][4 * g4 + 3] * rstd * sg[3]);
                    *(LAS u32x2*)(lds + AT_OOFF + ql * 272 + e0 * 2) = w;
                }
        }
        __syncthreads();
#pragma unroll
        for (int i = 0; i < 4; ++i) {
            const int cid = tid + 512 * i, row = cid >> 4, ch = cid & 15;
            const u32x4 w = *(const LAS u32x4*)(lds + AT_OOFF + row * 272 + ch * 16);
            *(u32x4*)(OUTP + ((size_t)(b * SEQL + qb * 128 + row)) * D + hd * 128 + ch * 8) = w;
        }
        __syncthreads();
    }
#undef AT_DMA
}

#define XB_TMO      128
#define XB_XCNT(j)  (256  + 64 * (j))
#define XB_XSUB(j)  (1280 + 64 * (j))
#define XB_XGEN(j)  (2304 + 64 * (j))
#define XB_TOP      3328
#define XB_TOPGEN   3392
#define XCD_BAR_WORDS 3456
#define XB_SPIN_CAP (1u << 18)

__device__ __forceinline__ unsigned xb_ld(unsigned* p)              { return __hip_atomic_load(p, __ATOMIC_RELAXED, __HIP_MEMORY_SCOPE_AGENT); }
__device__ __forceinline__ unsigned xb_add(unsigned* p, unsigned v) { return __hip_atomic_fetch_add(p, v, __ATOMIC_RELAXED, __HIP_MEMORY_SCOPE_AGENT); }
__device__ __forceinline__ unsigned xb_xcc_id() { return (unsigned)__builtin_amdgcn_s_getreg((3 << 11) | 20) & 0xFu; }
#define XB_SPIN(cond, bar) do { unsigned _sp = 0; while (cond) { __builtin_amdgcn_s_sleep(1); \
    if ((++_sp & 255u) == 0u) { if (xb_ld(&(bar)[XB_TMO])) break; if (_sp > XB_SPIN_CAP) { atomicAdd(&(bar)[XB_TMO], 1u); break; } } } } while (0)

struct XcdBarrier {
    unsigned* bar; unsigned x;
    volatile LAS unsigned* st;
};

__device__ __forceinline__ XcdBarrier xcd_barrier_post(unsigned* bar, volatile LAS unsigned* st) {
    XcdBarrier b; b.bar = bar; b.x = xb_xcc_id(); b.st = st;
    if (threadIdx.x == 0) (void)xb_add(&bar[XB_XCNT(b.x)], 1u);
    return b;
}
__device__ __forceinline__ void xcd_barrier_complete(unsigned* bar, unsigned x, unsigned& nloc, unsigned& nx) {
    const unsigned G = gridDim.x * gridDim.y * gridDim.z;
    unsigned sum, cnt, mine, sp = 0u;
    for (;;) {
        sum = 0u; cnt = 0u; mine = 0u;
#pragma unroll
        for (unsigned j = 0; j < 16; ++j) { const unsigned c = xb_ld(&bar[XB_XCNT(j)]); sum += c; cnt += (c > 0u) ? 1u : 0u; mine = (j == x) ? c : mine; }
        if (sum == G) break;
        __builtin_amdgcn_s_sleep(1);
        if ((++sp & 255u) == 0u) { if (xb_ld(&bar[XB_TMO])) break; if (sp > XB_SPIN_CAP) { atomicAdd(&bar[XB_TMO], 1u); break; } }
    }
    nloc = mine > 0u ? mine : 1u; nx = cnt > 0u ? cnt : 1u;
}

__device__ __forceinline__ void xcd_barrier(const XcdBarrier& b) {
    asm volatile("s_waitcnt vmcnt(0)" ::: "memory");
    __syncthreads();
    if (threadIdx.x == 0) {
        unsigned* bar = b.bar;
        __builtin_amdgcn_s_waitcnt(0);
        unsigned nloc = b.st[0], nx = b.st[1];
        if (nloc == 0u) { xcd_barrier_complete(bar, b.x, nloc, nx); b.st[0] = nloc; b.st[1] = nx; }
        const unsigned old = xb_add(&bar[XB_XSUB(b.x)], 1u);
        const unsigned gen = old / nloc;
        if (old + 1u == (gen + 1u) * nloc) {
            __builtin_amdgcn_fence(__ATOMIC_RELEASE, "agent");
            asm volatile("s_waitcnt vmcnt(0)" ::: "memory");
            const unsigned og = xb_add(&bar[XB_TOP], 1u);
            const unsigned tg = og / nx;
            if (og + 1u == (tg + 1u) * nx) xb_add(&bar[XB_TOPGEN], 1u);
            else XB_SPIN(xb_ld(&bar[XB_TOPGEN]) == tg, bar);
            __builtin_amdgcn_fence(__ATOMIC_ACQUIRE, "agent");
            xb_add(&bar[XB_XGEN(b.x)], 1u);
            asm volatile("s_waitcnt vmcnt(0)" ::: "memory");
        } else {
            XB_SPIN(xb_ld(&bar[XB_XGEN(b.x)]) == gen, bar);
            __builtin_amdgcn_fence(__ATOMIC_ACQUIRE, "agent");
            asm volatile("s_waitcnt vmcnt(0)" ::: "memory");
        }
    }
    __syncthreads();
}

__global__ void __launch_bounds__(512, 2) mega_fwd(Params p) {
    extern __shared__ __attribute__((aligned(16))) unsigned char shm[];
    cg::grid_group grid = cg::this_grid();
    LAS unsigned char* lds = (LAS unsigned char*)shm;
    unsigned char* ws = p.ws;
    volatile LAS unsigned* xbst = (volatile LAS unsigned*)(lds + 131072 + 4080);
    if (threadIdx.x < 4) xbst[threadIdx.x] = 0u;
    __syncthreads();
    const XcdBarrier xbar = xcd_barrier_post((unsigned*)(ws + WS_BAR), xbst);
    const float* x = p.in[0]; const float* ctx = p.in[2]; const float* ng = p.in[6];
    bf16_t* XN = (bf16_t*)(ws + WS_XN); bf16_t* ACT = (bf16_t*)(ws + WS_ACT); bf16_t* H = (bf16_t*)(ws + WS_H);
    bf16_t* ZT = (bf16_t*)(ws + WS_ZT); bf16_t* Qb = (bf16_t*)(ws + WS_Q); bf16_t* Kb = (bf16_t*)(ws + WS_K); bf16_t* VTb = (bf16_t*)(ws + WS_VT);
    bf16_t* HY = (bf16_t*)(ws + WS_HY); bf16_t* BUFG = (bf16_t*)(ws + WS_BUFG); bf16_t* MERGED = (bf16_t*)(ws + WS_MERGED); bf16_t* Y = (bf16_t*)(ws + WS_Y);
    const bf16_t* WA = (const bf16_t*)(ws + WS_WA); const bf16_t* WB = (const bf16_t*)(ws + WS_WB); const bf16_t* WG = (const bf16_t*)(ws + WS_WG);
    const float* ROPE = (const float*)(ws + WS_ROPE);

    p0_adaln(p, shm);
    p0_h3(p);
    {
        const int bx = (int)blockIdx.x, G = (int)gridDim.x;
        if (G == 256) { if (bx < 144) convert_tiles(p, shm, bx, 144, 1872, 0); else convert_tiles(p, shm, 1872 + bx - 144, 112, 4160, 0); }
        else convert_tiles(p, shm, bx, G, 4160, 0);
    }
    if (p.out == nullptr) grid.sync();
    xcd_barrier(xbar);
    row_phase<false, 0, 0, true>(p, nullptr, x, ctx, nullptr, XN, TT, nullptr, 0.f, 0, ng + 0 * D, 0, 1);
    p1_filter(p, shm);
    xcd_barrier(xbar);
    { EpiSwiGLU E{ACT}; run_gemm(lds, XN, (const bf16_t*)(ws + WS_WFF_IN0), TT, 2 * FF, D, E); }
    {
        const int bx = (int)blockIdx.x, G = (int)gridDim.x;
        if (G == 256) { if (bx >= 176) convert_tiles(p, shm, bx - 176, 80, 960, 2); }
        else convert_tiles(p, shm, bx, G, 960, 2);
    }
    xcd_barrier(xbar);
    { auto E = mk_epi<0>(H, D); run_gemm(lds, ACT, (const bf16_t*)(ws + WS_WFF_OUT0), T, D, FF, E); }
    xcd_barrier(xbar);
    { auto E = mk_epi<0>(H + (size_t)T * D, D); run_gemm(lds, ACT + (size_t)T * FF, (const bf16_t*)(ws + WS_WFF_OUT0), TC, D, FF, E, 0, 32); }
    if ((int)blockIdx.x < 32) convert_tiles(p, shm, (int)blockIdx.x, 32, 512, 3);
    row_phase<true, 0, 2, true>(p, H, x, ctx, p.out, XN, T, ng + 1 * D, 0.5f, 2, ng + 2 * D, 3, 4, 0, (int)gridDim.x > 64 ? 32 : 0);
    xcd_barrier(xbar);
    row_phase<true, 0, 0, true>(p, H, x, ctx, nullptr, XN, TT, ng + 1 * D, 0.5f, 2, ng + 2 * D, 3, 4, T, 0);
    { auto E = mk_epi<0>(ZT, T); run_gemm(lds, WA, XN, 3072, T, D, E); }
    xcd_barrier(xbar);
    hyena_phase(p, lds);
    xcd_barrier(xbar);
    { auto E = mk_epi<5>(VTb, LK); E.ctpb = 16; E.cbstride = (long)D * LK; run_gemm(lds, WA + (size_t)3072 * D, XN, 1024, T, D, E); }
    { auto E = mk_epi<5>(VTb, LK); E.ctpb = 1; E.cbstride = (long)D * LK; E.coloff = SEQL; run_gemm(lds, WA + (size_t)3072 * D, XN + (size_t)T * D, 1024, TC, D, E, 64); }
    { EpiQK E; E.q = mk_epi<1>(Qb, D); E.q.rope = ROPE; E.q.scale = 0.125f * 1.4426950408889634f;
      E.k = mk_epi<1>(Kb, D); E.k.rope = ROPE; E.k.scale = 1.0f; E.k.rtpb = 16; E.k.rbstride = LK;
      run_gemm(lds, XN, WB, T, 2048, D, E); }
    { auto E = mk_epi<0>(Kb, D); E.rtpb = 1; E.rbstride = LK; E.rowoff = SEQL; run_gemm(lds, XN + (size_t)T * D, WB + (size_t)1024 * D, TC, 1024, D, E, 128); }
    {
        const int bx = (int)blockIdx.x, G = (int)gridDim.x;
        if (G == 256) { if (!((bx >= 64 && bx < 96) || (bx >= 128 && bx < 160))) { const int idx = bx < 64 ? bx : (bx < 128 ? bx - 32 : bx - 64); convert_tiles(p, shm, idx, 192, 1408, 1); } }
        else convert_tiles(p, shm, bx, G, 1408, 1);
    }
    xcd_barrier(xbar);
    attn_phase(p, lds, Qb);
    transpose_phase(p, shm);
    xcd_barrier(xbar);
    { auto E = mk_epi<2>(BUFG, 2 * D); run_gemm(lds, XN, WG, T, 2048, D, E); }
    { auto E = mk_epi<3>(MERGED, D, BUFG); E.ldg = 2 * D; run_gemm(lds, HY, (const bf16_t*)(ws + WS_WHY), T, 1024, D, E); }
    { auto E = mk_epi<4>(MERGED, D, BUFG + D); E.ldg = 2 * D; run_gemm(lds, Qb, (const bf16_t*)(ws + WS_WDA), T, 1024, D, E); }
    xcd_barrier(xbar);
    { auto E = mk_epi<0>(Y, D); run_gemm(lds, MERGED, (const bf16_t*)(ws + WS_WO), T, 1024, D, E); }
    xcd_barrier(xbar);
    row_phase<true, 1, 2, true>(p, Y, p.out, nullptr, ws + WS_MERGED, XN, T, ng + 3 * D, 1.0f, 5, ng + 4 * D, 6, 7);
    xcd_barrier(xbar);
    { EpiSwiGLU E{ACT}; run_gemm(lds, XN, (const bf16_t*)(ws + WS_WFF_IN1), T, 2 * FF, D, E); }
    xcd_barrier(xbar);
    { auto E = mk_epi<0>(H, D); run_gemm(lds, ACT, (const bf16_t*)(ws + WS_WFF_OUT1), T, D, FF, E); }
    xcd_barrier(xbar);
    row_phase<true, 1, 1, false>(p, H, ws + WS_MERGED, nullptr, p.out, nullptr, T, ng + 5 * D, 0.5f, 8, nullptr, 0, 0);
}

extern "C" void kernel_launch(void* const* d_in, const int* in_sizes, int n_in, void* d_out, int out_size, void* d_ws, size_t ws_size, hipStream_t stream) {
    static int grid_blocks = 0;
    if (!grid_blocks) {
        if (n_in != 29 || ws_size < WS_END) { fprintf(stderr, "kernel_launch: unexpected inputs (n_in %d, ws %zu)\n", n_in, ws_size); grid_blocks = -1; return; }
        int dev = 0, cus = 0, per_cu = 0;
        hipGetDevice(&dev);
        hipDeviceGetAttribute(&cus, hipDeviceAttributeMultiprocessorCount, dev);
        if (hipFuncSetAttribute((const void*)mega_fwd, hipFuncAttributeMaxDynamicSharedMemorySize, LDS_BYTES) != hipSuccess) { fprintf(stderr, "kernel_launch: hipFuncSetAttribute failed\n"); grid_blocks = -1; return; }
        hipOccupancyMaxActiveBlocksPerMultiprocessor(&per_cu, (const void*)mega_fwd, 512, LDS_BYTES);
        if (per_cu < 1) { fprintf(stderr, "kernel_launch: occupancy query returned %d\n", per_cu); per_cu = 1; }
        grid_blocks = cus * per_cu;
    }
    if (grid_blocks < 0) return;
    Params p{};
    for (int i = 0; i < 29; ++i) p.in[i] = (const float*)d_in[i];
    p.out = (float*)d_out; p.ws = (unsigned char*)d_ws;
    if (hipMemsetAsync((char*)d_ws + WS_BAR, 0, XCD_BAR_WORDS * 4, stream) != hipSuccess) { fprintf(stderr, "kernel_launch: memset of the barrier words failed\n"); return; }
    void* args[] = {&p};
    hipError_t e = hipLaunchCooperativeKernel((const void*)mega_fwd, dim3(grid_blocks), dim3(512), args, LDS_BYTES, stream);
    if (e != hipSuccess) fprintf(stderr, "kernel_launch: cooperative launch failed: %s (grid %d)\n", hipGetErrorString(e), grid_blocks);
}
```

```cpp
#include <hip/hip_runtime.h>
#include <cstdio>
namespace pg8 {
#define PG8_LAS __attribute__((address_space(3)))
typedef unsigned short bf16_t;
typedef short bf16x8 __attribute__((ext_vector_type(8)));
typedef float f32x4 __attribute__((ext_vector_type(4)));
typedef unsigned u32x4 __attribute__((ext_vector_type(4)));
constexpr int BM = 256, BK = 64, HALF = 128, HTB = HALF * BK * 2  , STAGE_BYTES = 8 * HTB, NXCD = 8, WGM = 8;

__host__ __device__ __forceinline__ int lds_byte(int r, int c) { const int st = (r >> 4) * 2 + (c >> 5), rr = r & 15, cc = c & 31, ob = rr * 64 + cc * 2; return st * 1024 + (ob ^ (((ob >> 9) & 1) << 5)); }
__host__ __device__ __forceinline__ void stage_rc(int b, int& R, int& C) { const int st = b / 1024, sb = b % 1024, swz = sb ^ (((sb >> 9) & 1) << 5); R = (st >> 1) * 16 + swz / 64; C = (st & 1) * 32 + (swz % 64) / 2; }
__host__ __device__ __forceinline__ int perm32(int rho) { const int n = rho >> 4, i = rho & 15; return 8 * (i >> 2) + 4 * n + (i & 3); }

struct Unit { int pm, pn; };
struct Gemm { const bf16_t* A; const bf16_t* Bt; int M, N, K; };

struct StaticOrder {
    int nM, nN, nwg, G, c;
    __host__ __device__ void init(int M, int N, int G_, int c_) { nM = M / BM; nN = N / BM; nwg = nM * nN; G = G_; c = c_; }
    __host__ __device__ bool next(int i, Unit& u) const {
        const long L = (long)i * G + c; if (L >= nwg) return false;
        int wgid = (int)L; { const int q = nwg / NXCD, r = nwg % NXCD, xcd = wgid % NXCD, off = wgid / NXCD; wgid = (xcd < r ? xcd * (q + 1) : r * (q + 1) + (xcd - r) * q) + off; }
        const int nig = WGM * nN, gid = wgid / nig, fm = gid * WGM, gsz = (nM - fm) < WGM ? (nM - fm) : WGM;
        u.pm = fm + ((wgid % nig) % gsz); u.pn = (wgid % nig) / gsz; return true;
    }
    __device__ __forceinline__ void a_ready(const Unit&) const {}
    __device__ __forceinline__ void done(const Unit&) const {}
};
__device__ __forceinline__ unsigned cvt_pk_bf16(float lo, float hi) { unsigned r; asm volatile("v_cvt_pk_bf16_f32 %0, %1, %2" : "=v"(r) : "v"(lo), "v"(hi)); return r; }
typedef float f32x2 __attribute__((ext_vector_type(2)));
template <class Epi, class Sched, bool STAMP = false>
__device__ __forceinline__ void gemm_phase(PG8_LAS unsigned char* lds, const Gemm g, const Sched& S, const Epi& E, unsigned long long* stamps) {
    int tid_ = threadIdx.x; asm volatile("" : "+v"(tid_)); const int tid = tid_, wid = __builtin_amdgcn_readfirstlane(tid >> 6), lane = tid & 63, wr = wid >> 2, wc = wid & 3, fr = lane & 15, fq = lane >> 4;
    const int K = g.K, nt = K / BK;
    int ts_lo = 0, ts_hi = 0, nts = 0; const unsigned long long rt_entry = STAMP ? (unsigned long long)wall_clock64() : 0ull;
#define PG8_STAMP() do { if (STAMP && wid == 0 && nts < 64) { const unsigned long long _c = (unsigned long long)clock64(); \
        ts_lo = (lane == nts) ? (int)(unsigned)_c : ts_lo; ts_hi = (lane == nts) ? (int)(unsigned)(_c >> 32) : ts_hi; ++nts; } } while (0)
    PG8_STAMP();
    unsigned voffA[2], voffB[2];
#pragma unroll
    for (int i = 0; i < 2; ++i) { int R, C; stage_rc(tid * 16 + i * 8192, R, C); const int Rb = Epi::PERM ? ((R & ~31) + perm32(R & 31)) : R;
        voffA[i] = (unsigned)(R * K + C) * 2u; voffB[i] = (unsigned)(Rb * K + C) * 2u; }
    const size_t kstep = (size_t)(BK * 2);
    const size_t hstep = (size_t)HALF * K * 2;
    const size_t tstep = 2 * hstep;
    const unsigned ldsw = (unsigned)wid * 1024u;
    const int aoff = lds_byte(wr * 64 + fr, fq * 8), boff = lds_byte(wc * 32 + fr, fq * 8);
#define PG8_SA(b, h) (((b) * 2 + (h)) * HTB)
#define PG8_SB(b, h) ((4 + (b) * 2 + (h)) * HTB)
#define PG8_STAGE(bufoff, gbase, voff) do { _Pragma("unroll") for (int _i = 0; _i < 2; ++_i) \
        __builtin_amdgcn_global_load_lds((const unsigned*)((const char*)(gbase) + (voff)[_i]), (PG8_LAS unsigned*)(lds + (bufoff) + ldsw + _i * 8192), 16, 0, 0); } while (0)
#define PG8_LDA(dst, b, h) do { _Pragma("unroll") for (int m = 0; m < 4; ++m) _Pragma("unroll") for (int k = 0; k < 2; ++k) dst[m][k] = *(const PG8_LAS bf16x8*)(lds + PG8_SA(b, h) + aoff + m * 2048 + k * 1024); } while (0)
#define PG8_LDB(dst, b, h) do { _Pragma("unroll") for (int n = 0; n < 2; ++n) _Pragma("unroll") for (int k = 0; k < 2; ++k) dst[n][k] = *(const PG8_LAS bf16x8*)(lds + PG8_SB(b, h) + boff + n * 2048 + k * 1024); } while (0)
#define PG8_MMA(ai, bj, At, Bt) do { __builtin_amdgcn_s_setprio(1); _Pragma("unroll") for (int m = 0; m < 4; ++m) _Pragma("unroll") for (int n = 0; n < 2; ++n) _Pragma("unroll") for (int k = 0; k < 2; ++k) \
        acc[ai][bj][m][n] = __builtin_amdgcn_mfma_f32_16x16x32_bf16(Bt[n][k], At[m][k], acc[ai][bj][m][n], 0, 0, 0); __builtin_amdgcn_s_setprio(0); } while (0)
#define PG8_WAIT_V(n) asm volatile("s_waitcnt vmcnt(" #n ")" ::: "memory")
#define PG8_WAIT_L(n) asm volatile("s_waitcnt lgkmcnt(" #n ")" ::: "memory")
#define PG8_BAR __builtin_amdgcn_s_barrier()
#define PG8_SCHED __builtin_amdgcn_sched_barrier(0)
    Unit cur, nxt; int ui = 0;
    if (!S.next(0, cur)) return;
    f32x4 acc[2][2][4][2];
#pragma unroll
    for (int a = 0; a < 2; ++a)
#pragma unroll
        for (int b = 0; b < 2; ++b)
#pragma unroll
            for (int m = 0; m < 4; ++m)
#pragma unroll
                for (int n = 0; n < 2; ++n) acc[a][b][m][n] = (f32x4){0.f, 0.f, 0.f, 0.f};
    bf16x8 At[4][2], B0[2][2], B1[2][2];
    const char* cA = (const char*)g.A + (size_t)cur.pm * tstep; const char* cB = (const char*)g.Bt + (size_t)cur.pn * tstep;
    S.a_ready(cur);
    PG8_STAGE(PG8_SB(0, 0), cB, voffB); PG8_STAGE(PG8_SA(0, 0), cA, voffA); PG8_STAGE(PG8_SB(0, 1), cB + hstep, voffB); PG8_STAGE(PG8_SA(0, 1), cA + hstep, voffA);
    if (wr == 1) PG8_BAR;
    PG8_WAIT_V(4); PG8_BAR;
    PG8_STAGE(PG8_SB(1, 0), cB + kstep, voffB); PG8_STAGE(PG8_SA(1, 0), cA + kstep, voffA); PG8_STAGE(PG8_SB(1, 1), cB + hstep + kstep, voffB);
    PG8_WAIT_V(6); PG8_BAR;
    PG8_STAMP();
    for (;;) {
        const bool has_next = S.next(ui + 1, nxt);
        const char* nA = has_next ? (const char*)g.A + (size_t)nxt.pm * tstep : cA; const char* nB = has_next ? (const char*)g.Bt + (size_t)nxt.pn * tstep : cB;
        for (int t = 0; t < nt; t += 2) {
            const bool last = (t == nt - 2);
            const char* a1 = cA + (size_t)(t + 1) * kstep;
            const char* a2 = last ? nA : cA + (size_t)(t + 2) * kstep; const char* b2 = last ? nB : cB + (size_t)(t + 2) * kstep;
            const char* a3 = a2 + kstep; const char* b3 = b2 + kstep;
            if (last && has_next) S.a_ready(nxt);
            PG8_LDB(B0, 0, 0); PG8_SCHED; PG8_LDA(At, 0, 0); PG8_STAGE(PG8_SA(1, 1), a1 + hstep, voffA);
            PG8_WAIT_L(8); PG8_BAR; PG8_WAIT_L(0); PG8_MMA(0, 0, At, B0); PG8_BAR; PG8_SCHED;
            PG8_LDB(B1, 0, 1); PG8_STAGE(PG8_SB(0, 0), b2, voffB);
            PG8_BAR; PG8_WAIT_L(0); PG8_MMA(0, 1, At, B1); PG8_BAR;
            PG8_LDA(At, 0, 1); PG8_STAGE(PG8_SA(0, 0), a2, voffA);
            PG8_BAR; PG8_WAIT_L(0); PG8_MMA(1, 0, At, B0); PG8_BAR; PG8_SCHED;
            PG8_STAGE(PG8_SB(0, 1), b2 + hstep, voffB);
            PG8_WAIT_V(6); PG8_BAR; PG8_MMA(1, 1, At, B1); PG8_BAR;
            PG8_LDB(B0, 1, 0); PG8_SCHED; PG8_LDA(At, 1, 0); PG8_STAGE(PG8_SA(0, 1), a2 + hstep, voffA);
            PG8_WAIT_L(8); PG8_BAR; PG8_WAIT_L(0); PG8_MMA(0, 0, At, B0); PG8_BAR; PG8_SCHED;
            PG8_LDB(B1, 1, 1); PG8_STAGE(PG8_SB(1, 0), b3, voffB);
            PG8_BAR; PG8_WAIT_L(0); PG8_MMA(0, 1, At, B1); PG8_BAR;
            PG8_LDA(At, 1, 1); PG8_STAGE(PG8_SA(1, 0), a3, voffA);
            PG8_BAR; PG8_WAIT_L(0); PG8_MMA(1, 0, At, B0); PG8_BAR; PG8_SCHED;
            PG8_STAGE(PG8_SB(1, 1), b3 + hstep, voffB);
            PG8_WAIT_V(6); PG8_BAR; PG8_MMA(1, 1, At, B1); PG8_BAR;
        }
        PG8_STAMP();
        if constexpr (!Epi::AFTER_DRAIN) { E(acc, cur, wr, wc, fr, fq); S.done(cur); }
        PG8_STAMP();
        if (!has_next) break;
#pragma unroll
        for (int a = 0; a < 2; ++a)
#pragma unroll
            for (int b = 0; b < 2; ++b)
#pragma unroll
                for (int m = 0; m < 4; ++m)
#pragma unroll
                    for (int n = 0; n < 2; ++n) acc[a][b][m][n] = (f32x4){0.f, 0.f, 0.f, 0.f};
        cur = nxt; cA = nA; cB = nB; ++ui;
    }
    PG8_WAIT_V(0);
    if (wr == 0) PG8_BAR;
    PG8_BAR;
    if constexpr (Epi::AFTER_DRAIN) { E.fused(acc, cur, wr, wc, fr, fq, lds, wid, lane); S.done(cur); }
    PG8_STAMP();
    if (STAMP && wid == 0) { stamps[lane] = lane < nts ? (((unsigned long long)(unsigned)ts_hi << 32) | (unsigned)ts_lo) : 0ull;
        if (lane == 62) stamps[62] = rt_entry; if (lane == 63) stamps[63] = (unsigned long long)wall_clock64(); }
#undef PG8_STAMP
#undef PG8_SA
#undef PG8_SB
#undef PG8_STAGE
#undef PG8_LDA
#undef PG8_LDB
#undef PG8_MMA
#undef PG8_WAIT_V
#undef PG8_WAIT_L
#undef PG8_BAR
#undef PG8_SCHED
}
}

#include <hip/hip_cooperative_groups.h>
namespace cg = cooperative_groups;
using pg8::bf16_t; using pg8::f32x4; using pg8::bf16x8; using pg8::u32x4; using pg8::Unit;
#define LAS __attribute__((address_space(3)))
#define DI __device__ __forceinline__
typedef float f32x16 __attribute__((ext_vector_type(16)));
typedef float f32x2v __attribute__((ext_vector_type(2)));
typedef __bf16 bf16x2n __attribute__((ext_vector_type(2)));
typedef unsigned u32x2 __attribute__((ext_vector_type(2)));

constexpr int D = 1024, NBATCH = 8, SEQL = 4096, T = NBATCH * SEQL, CL = 256, TC = NBATCH * CL, TT = T + TC, FF = 2816, LK = SEQL + CL;
constexpr float EPS = 1e-6f;
constexpr size_t MiB = 1048576;
constexpr size_t WS_WFF_IN0 = 0, WS_WFF_IN1 = 11 * MiB, WS_WFF_OUT0 = 22 * MiB, WS_WFF_OUT1 = 22 * MiB + MiB * 11 / 2, WS_WA = 33 * MiB, WS_WB = 41 * MiB, WS_WG = 45 * MiB,
                 WS_WHY = 49 * MiB, WS_WDA = 51 * MiB, WS_WO = 53 * MiB, WS_MOD = 55 * MiB, WS_H3 = 55 * MiB + MiB / 2, WS_ROPE = 56 * MiB + MiB / 2, WS_BAR = 57 * MiB,
                 WS_XN = 58 * MiB, WS_ACT = 126 * MiB, WS_H = 313 * MiB, WS_ZT = 126 * MiB, WS_HYT = 382 * MiB, WS_Q = 126 * MiB, WS_K = 190 * MiB, WS_VT = 258 * MiB,
                 WS_HY = 446 * MiB, WS_BUFG = 254 * MiB, WS_MERGED = 382 * MiB, WS_Y = 190 * MiB, WS_GIMG = 446 * MiB, WS_END = 510 * MiB;
constexpr int IMGN = 16448, OFFO = 8226;
constexpr int LDS_BYTES = 131072 + 4096;

struct Params { const float* in[29]; float* out; unsigned char* ws; };

DI float bflo(unsigned w) { return __uint_as_float(w << 16); }
DI float bfhi(unsigned w) { return __uint_as_float(w & 0xffff0000u); }
DI float bf2f(unsigned short b) { return __uint_as_float(((unsigned)b) << 16); }
DI unsigned pk(float lo, float hi) { f32x2v v = {lo, hi}; bf16x2n b = __builtin_convertvector(v, bf16x2n); return __builtin_bit_cast(unsigned, b); }
DI unsigned short f2bf(float x) { return (unsigned short)(pk(x, 0.f) & 0xffffu); }
DI float shx(float v, int lane, int o) { return __int_as_float(__builtin_amdgcn_ds_bpermute((lane ^ o) << 2, __float_as_int(v))); }
DI float shl(float v, int src) { return __int_as_float(__builtin_amdgcn_ds_bpermute(src << 2, __float_as_int(v))); }
DI float wave_sum(float v, int lane) {
#pragma unroll
    for (int o = 32; o >= 1; o >>= 1) v += shx(v, lane, o);
    return v; }
DI float fast_exp2(float x) { return __builtin_amdgcn_exp2f(x); }
DI float siluf(float x) { return x * __builtin_amdgcn_rcpf(1.0f + __expf(-x)); }
DI float sigmf(float x) { return __builtin_amdgcn_rcpf(1.0f + __expf(-x)); }
DI int tid_opaque() { int t = threadIdx.x; asm volatile("" : "+v"(t)); return t; }
#define MFMA32(a, b, c) __builtin_amdgcn_mfma_f32_32x32x16_bf16((a), (b), (c), 0, 0, 0)

struct EpiSwiGLU {
    static constexpr bool PERM = true, AFTER_DRAIN = false;
    bf16_t* O;
    __device__ __forceinline__ void operator()(const f32x4 (&acc)[2][2][4][2], const Unit& u, int wr, int wc, int fr, int fq) const {
        const int row0 = u.pm * 256 + wr * 64 + fr, col0 = u.pn * 128 + wc * 32 + 8 * fq;
#pragma unroll
        for (int ai = 0; ai < 2; ++ai)
#pragma unroll
            for (int m = 0; m < 4; ++m) {
                bf16_t* rowp = O + (size_t)(row0 + ai * 128 + m * 16) * FF + col0;
                const f32x4 g0 = acc[ai][0][m][0], g1 = acc[ai][0][m][1], u0 = acc[ai][1][m][0], u1 = acc[ai][1][m][1];
                u32x4 w;
                w.x = pk(siluf(g0[0]) * u0[0], siluf(g0[1]) * u0[1]); w.y = pk(siluf(g0[2]) * u0[2], siluf(g0[3]) * u0[3]);
                w.z = pk(siluf(g1[0]) * u1[0], siluf(g1[1]) * u1[1]); w.w = pk(siluf(g1[2]) * u1[2], siluf(g1[3]) * u1[3]);
                *(u32x4*)rowp = w;
            }
    }
};
template <int MODE> struct EpiGen {
    static constexpr bool PERM = true, AFTER_DRAIN = false;
    bf16_t* O; long ldc; int rtpb; long rbstride; int rowoff; int ctpb; long cbstride; int coloff; const bf16_t* G; const float* rope; float scale; long ldg;
    __device__ __forceinline__ void operator()(const f32x4 (&acc)[2][2][4][2], const Unit& u, int wr, int wc, int fr, int fq) const {
        const long rbase = (long)(u.pm / rtpb) * rbstride + (long)(u.pm % rtpb) * 256 + rowoff;
        const long cboff = (long)(u.pn / ctpb) * cbstride;
        const int cbase = (u.pn % ctpb) * 256 + coloff;
#pragma unroll
        for (int ai = 0; ai < 2; ++ai)
#pragma unroll
            for (int m = 0; m < 4; ++m) {
                const int rl = ai * 128 + wr * 64 + m * 16 + fr;
                const long row = rbase + rl;
                f32x4 cs0 = {1.f, 0.f, 1.f, 0.f}, cs1 = {1.f, 0.f, 1.f, 0.f};
                if (MODE == 1) {
                    const int t = (u.pm & 15) * 256 + rl;
                    const int pos = (wc & 1) ? (t & 63) : (t >> 6);
                    const float* rp = rope + pos * 32 + 8 * fq;
                    cs0 = *(const f32x4*)rp; cs1 = *(const f32x4*)(rp + 4);
                }
#pragma unroll
                for (int bj = 0; bj < 2; ++bj) {
                    const int col = cbase + bj * 128 + wc * 32 + 8 * fq;
                    const size_t off = (size_t)cboff + (size_t)row * ldc + col;
                    f32x4 v0 = acc[ai][bj][m][0], v1 = acc[ai][bj][m][1];
                    if (MODE == 1) {
                        f32x4 a, b;
                        a[0] = v0[0] * cs0[0] - v0[1] * cs0[1]; a[1] = v0[0] * cs0[1] + v0[1] * cs0[0];
                        a[2] = v0[2] * cs0[2] - v0[3] * cs0[3]; a[3] = v0[2] * cs0[3] + v0[3] * cs0[2];
                        b[0] = v1[0] * cs1[0] - v1[1] * cs1[1]; b[1] = v1[0] * cs1[1] + v1[1] * cs1[0];
                        b[2] = v1[2] * cs1[2] - v1[3] * cs1[3]; b[3] = v1[2] * cs1[3] + v1[3] * cs1[2];
                        v0 = a * scale; v1 = b * scale;
                    }
                    if (MODE == 2) {
#pragma unroll
                        for (int j = 0; j < 4; ++j) { v0[j] = sigmf(v0[j]); v1[j] = sigmf(v1[j]); }
                    }
                    if (MODE == 3 || MODE == 4) {
                        const u32x4 g = *(const u32x4*)(G + (size_t)row * ldg + col);
                        v0[0] *= bflo(g.x); v0[1] *= bfhi(g.x); v0[2] *= bflo(g.y); v0[3] *= bfhi(g.y);
                        v1[0] *= bflo(g.z); v1[1] *= bfhi(g.z); v1[2] *= bflo(g.w); v1[3] *= bfhi(g.w);
                    }
                    if (MODE == 4) {
                        const u32x4 o = *(const u32x4*)(O + off);
                        v0[0] += bflo(o.x); v0[1] += bfhi(o.x); v0[2] += bflo(o.y); v0[3] += bfhi(o.y);
                        v1[0] += bflo(o.z); v1[1] += bfhi(o.z); v1[2] += bflo(o.w); v1[3] += bfhi(o.w);
                    }
                    u32x4 w; w.x = pk(v0[0], v0[1]); w.y = pk(v0[2], v0[3]); w.z = pk(v1[0], v1[1]); w.w = pk(v1[2], v1[3]);
                    if (MODE == 5) {
                        const int c16 = col & ~15, p0 = (col & 8) ? 4 : 0;
                        const size_t o2 = (size_t)cboff + (size_t)row * ldc + c16 + p0;
                        *(u32x2*)(O + o2) = (u32x2){w.x, w.y}; *(u32x2*)(O + o2 + 8) = (u32x2){w.z, w.w};
                    } else
                    *(u32x4*)(O + off) = w;
                }
            }
    }
};
struct EpiQK {
    static constexpr bool PERM = true, AFTER_DRAIN = false;
    EpiGen<1> q, k;
    __device__ __forceinline__ void operator()(const f32x4 (&acc)[2][2][4][2], const Unit& u, int wr, int wc, int fr, int fq) const {
        if (u.pn < 4) q(acc, u, wr, wc, fr, fq);
        else { Unit u2; u2.pm = u.pm; u2.pn = u.pn - 4; k(acc, u2, wr, wc, fr, fq); }
    }
};
template <int MODE> DI EpiGen<MODE> mk_epi(bf16_t* O, long ldc, const bf16_t* G = nullptr) {
    EpiGen<MODE> e; e.O = O; e.ldc = ldc; e.rtpb = 1 << 20; e.rbstride = 0; e.rowoff = 0; e.ctpb = 1 << 20; e.cbstride = 0; e.coloff = 0; e.G = G; e.rope = nullptr; e.scale = 1.f; e.ldg = ldc; return e; }

template <class Epi> DI void run_gemm(LAS unsigned char* lds, const bf16_t* A, const bf16_t* Bt, int M, int N, int K, const Epi& E, int crot = 0, int gsub = 0) {
    if (gsub > 0 && (int)blockIdx.x >= gsub) return;
    const int G = gsub > 0 ? gsub : (int)gridDim.x; const int c = ((int)blockIdx.x + G - crot) % G;
    pg8::Gemm g{A, Bt, M, N, K}; pg8::StaticOrder S; S.init(M, N, G, c);
    pg8::gemm_phase<Epi, pg8::StaticOrder, false>(lds, g, S, E, nullptr);
}

DI int colmap(int w, int n) {
    switch (w) {
        case 0: case 1: { const int pn = n >> 8, rr = n & 255; return rr < 128 ? pn * 128 + rr : FF + pn * 128 + (rr - 128); }
        case 4: return n < 3072 ? n : 5120 + (n - 3072);
        case 5: { const int base = n < 1024 ? 3072 : 4096; const int x = n & 1023; const int hm = x >> 6, pp = x & 63; const int pi = pp >> 1, half = pp & 1, axis = pi >> 4, f = pi & 15;
                  return base + hm * 64 + axis * 32 + half * 16 + f; }
        case 6: return 6144 + n;
        default: return n;
    }
}
__device__ __forceinline__ void convert_tiles(const Params& p, unsigned char* shm, int v_first, int v_step, int v_end, int mode) {
    float* tile = (float*)shm;
    const int tid = tid_opaque();
    for (int v = v_first; v < v_end; v += v_step) {
        const int ti = mode == 1 ? 1408 + v : mode == 2 ? (v < 704 ? 3520 + v : 6784 + (v - 704)) : (v < 1408 ? v : (v < 2112 ? v + 1408 : v + 2112));
        int w, loc;
        if (ti < 1408) { w = 0; loc = ti; } else if (ti < 2816) { w = 1; loc = ti - 1408; } else if (ti < 3520) { w = 2; loc = ti - 2816; } else if (ti < 4224) { w = 3; loc = ti - 3520; }
        else if (ti < 5248) { w = 4; loc = ti - 4224; } else if (ti < 5760) { w = 5; loc = ti - 5248; } else if (ti < 6272) { w = 6; loc = ti - 5760; }
        else if (ti < 6528) { w = 7; loc = ti - 6272; } else if (ti < 6784) { w = 8; loc = ti - 6528; } else { w = 9; loc = ti - 6784; }
        const float* src; int ld, K; size_t dsto;
        if (w == 0) { src = p.in[7]; ld = 2 * FF; K = 1024; dsto = WS_WFF_IN0; }
        else if (w == 1) { src = p.in[7] + (size_t)1024 * 2 * FF; ld = 2 * FF; K = 1024; dsto = WS_WFF_IN1; }
        else if (w == 2) { src = p.in[8]; ld = 1024; K = FF; dsto = WS_WFF_OUT0; }
        else if (w == 3) { src = p.in[8] + (size_t)FF * 1024; ld = 1024; K = FF; dsto = WS_WFF_OUT1; }
        else if (w == 4) { src = p.in[9]; ld = 8192; K = 1024; dsto = WS_WA; }
        else if (w == 5) { src = p.in[9]; ld = 8192; K = 1024; dsto = WS_WB; }
        else if (w == 6) { src = p.in[9]; ld = 8192; K = 1024; dsto = WS_WG; }
        else if (w == 7) { src = p.in[26]; ld = 1024; K = 1024; dsto = WS_WHY; }
        else if (w == 8) { src = p.in[27]; ld = 1024; K = 1024; dsto = WS_WDA; }
        else { src = p.in[28]; ld = 1024; K = 1024; dsto = WS_WO; }
        bf16_t* dst = (bf16_t*)(p.ws + dsto);
        const int kT = K >> 6, kt = loc % kT, nt = loc / kT, k0 = kt * 64, n0 = nt * 64;
        {
            const int nl = tid & 63, kq = tid >> 6; const int sc = colmap(w, n0 + nl);
#pragma unroll
            for (int i = 0; i < 8; ++i) { const int kl = kq + 8 * i; tile[kl * 65 + nl] = __builtin_nontemporal_load(src + (size_t)(k0 + kl) * ld + sc); }
        }
        __syncthreads();
        {
            const int nl = tid >> 3, kc = (tid & 7) * 8;
            u32x4 wv; float v[8];
#pragma unroll
            for (int j = 0; j < 8; ++j) v[j] = tile[(kc + j) * 65 + nl];
            wv.x = pk(v[0], v[1]); wv.y = pk(v[2], v[3]); wv.z = pk(v[4], v[5]); wv.w = pk(v[6], v[7]);
            __builtin_nontemporal_store(wv, (u32x4*)(dst + (size_t)(n0 + nl) * K + k0 + kc));
        }
        __syncthreads();
    }
}
__device__ __forceinline__ void p0_adaln(const Params& p, unsigned char* shm) {
    if (blockIdx.x >= 144) return;
    float* ssil = (float*)shm;
    float* red = ssil + 9 * 1024;
    const int tid = tid_opaque();
    const float* c = p.in[1]; const float* cctx = p.in[3]; const float* wada = p.in[4]; const float* bada = p.in[5];
    float* MOD = (float*)(p.ws + WS_MOD);
    for (int i = tid; i < 9216; i += 512) { const int b = i >> 10, k = i & 1023; const float v = b < 8 ? c[b * 1024 + k] : cctx[k]; ssil[i] = siluf(v); }
    __syncthreads();
    for (int u = blockIdx.x; u < 144; u += gridDim.x) {
        const int jl = tid & 63, kg = tid >> 6, j = u * 64 + jl;
        float a[9];
#pragma unroll
        for (int b = 0; b < 9; ++b) a[b] = 0.f;
        for (int k = kg * 128; k < kg * 128 + 128; ++k) {
            const float wv = wada[(size_t)k * 9216 + j];
#pragma unroll
            for (int b = 0; b < 9; ++b) a[b] += ssil[b * 1024 + k] * wv;
        }
#pragma unroll
        for (int b = 0; b < 9; ++b) red[(kg * 9 + b) * 64 + jl] = a[b];
        __syncthreads();
        for (int i = tid; i < 576; i += 512) {
            const int b = i >> 6, j2 = i & 63; float s = 0.f;
#pragma unroll
            for (int g = 0; g < 8; ++g) s += red[(g * 9 + b) * 64 + j2];
            MOD[b * 9216 + u * 64 + j2] = s + bada[u * 64 + j2];
        }
        __syncthreads();
    }
}
__device__ __forceinline__ void p0_h3(const Params& p) {
    const int tid = tid_opaque(); const int lane = tid & 63, wave = tid >> 6;
    const float* w1 = p.in[12]; const float* b1 = p.in[13]; const float* w2 = p.in[14]; const float* b2 = p.in[15]; const float* w3 = p.in[16]; const float* b3 = p.in[17]; const float* freq = p.in[19];
    float* H3 = (float*)(p.ws + WS_H3);
    const float fr = freq[lane];
    for (int t = blockIdx.x * 8 + wave; t < SEQL; t += gridDim.x * 8) {
        const float tl = (float)t / 4095.0f;
        const float w = 6.283185307179586f * (float)t / 4096.0f;
        float z = 0.f;
        if (lane == 0) z = tl;
        else if (lane <= 16) { const float f = 1e-4f + (float)(lane - 1) * ((15.0f - 1e-4f) / 15.0f); z = cosf(f * w); }
        else if (lane <= 32) { const float f = 1e-4f + (float)(lane - 17) * ((15.0f - 1e-4f) / 15.0f); z = -sinf(f * w); }
        float h = b1[lane];
        for (int i = 0; i < 33; ++i) h += shl(z, i) * w1[i * 64 + lane];
        h = sinf(fr * h);
        float h2 = b2[lane];
        for (int i = 0; i < 64; ++i) h2 += shl(h, i) * w2[i * 64 + lane];
        h2 = sinf(fr * h2);
        float h3 = b3[lane];
        for (int i = 0; i < 64; ++i) h3 += shl(h2, i) * w3[i * 64 + lane];
        h3 = sinf(fr * h3);
        H3[t * 64 + lane] = h3;
    }
    if (blockIdx.x == gridDim.x - 1) {
        float* ROPE = (float*)(p.ws + WS_ROPE);
        for (int idx = tid; idx < 1024; idx += 512) {
            const int pos = idx >> 4, f = idx & 15;
            const float inv = powf(10000.0f, -(float)(2 * f) / 32.0f);
            const float ang = (float)pos * inv;
            ROPE[idx * 2] = cosf(ang); ROPE[idx * 2 + 1] = sinf(ang);
        }
    }
}
__device__ __forceinline__ void p1_filter(const Params& p, unsigned char* shm) {
    float* vals = (float*)shm;
    float* w4s = (float*)(shm + 131072);
    float* red = w4s + 512;
    const int tid = tid_opaque(), lane = tid & 63, wave = tid >> 6;
    const float* w4 = p.in[18]; const float* H3 = (const float*)(p.ws + WS_H3);
    unsigned short* GIMG = (unsigned short*)(p.ws + WS_GIMG);
    for (int u = blockIdx.x; u < 256; u += gridDim.x) {
        const int c0 = u * 4;
        { const int ii = tid >> 3, q = tid & 7, cc = q >> 1, dir = q & 1; w4s[tid] = w4[(size_t)ii * 2048 + dir * 1024 + c0 + cc]; }
        __syncthreads();
        float sums[4] = {0.f, 0.f, 0.f, 0.f};
#pragma unroll 1
        for (int it = 0; it < 8; ++it) {
            const int t = tid + 512 * it;
            float a[8];
#pragma unroll
            for (int q = 0; q < 8; ++q) a[q] = 0.f;
            const f32x4* hp = (const f32x4*)(H3 + (size_t)t * 64);
#pragma unroll 2
            for (int i4 = 0; i4 < 16; ++i4) {
                const f32x4 hv = hp[i4];
#pragma unroll
                for (int e = 0; e < 4; ++e) {
                    const float* wr = w4s + (i4 * 4 + e) * 8;
#pragma unroll
                    for (int q = 0; q < 8; ++q) a[q] += hv[e] * wr[q];
                }
            }
            const float tl = (float)t / 4095.0f;
#pragma unroll
            for (int cc = 0; cc < 4; ++cc) {
                const float delta = 3.0701134573f + (float)(c0 + cc) * ((15.3505672866f - 3.0701134573f) / 1023.0f);
                const float dec = expf(-tl * delta);
                const float f = a[cc * 2] * dec, bwd = a[cc * 2 + 1] * dec;
                vals[t * 8 + cc * 2] = f; vals[t * 8 + cc * 2 + 1] = bwd;
                sums[cc] += fabsf(f) + (t >= 1 ? fabsf(bwd) : 0.f);
            }
        }
#pragma unroll
        for (int cc = 0; cc < 4; ++cc) { const float s = wave_sum(sums[cc], lane); if (lane == 0) red[wave * 4 + cc] = s; }
        __syncthreads();
        float inv[4];
#pragma unroll
        for (int cc = 0; cc < 4; ++cc) { float s = 0.f;
#pragma unroll
            for (int g = 0; g < 8; ++g) s += red[g * 4 + cc];
            inv[cc] = 1.0f / (s + EPS); }
#pragma unroll 1
        for (int it = 0; it < 8; ++it) {
            const int t = tid + 512 * it;
#pragma unroll
            for (int cc = 0; cc < 4; ++cc) {
                unsigned short* img = GIMG + (size_t)(c0 + cc) * IMGN;
                const unsigned short f = f2bf(vals[t * 8 + cc * 2] * inv[cc]), bb = f2bf(vals[t * 8 + cc * 2 + 1] * inv[cc]);
                const int pf = SEQL - t;
                img[pf] = f; img[OFFO + pf - 1] = f;
                if (t >= 1) { const int pb = SEQL + t; img[pb] = bb; img[OFFO + pb - 1] = bb; }
                else { img[0] = 0; img[OFFO + 8191] = 0; }
            }
        }
        __syncthreads();
    }
}
template <bool HAS_SRC, int RES_IN, int RES_OUT, bool WRITE_XN>
__device__ __forceinline__ void row_phase(const Params& p, const bf16_t* SRC, const void* res_lat, const float* res_ctx, void* RES_OUT_P, bf16_t* XN, int nrows,
                          const float* g_post, float gmul, int gate_idx, const float* g_pre, int shift_idx, int scale_idx, int row_begin = 0, int bfirst = 0) {
    const int tid = tid_opaque(); const int lane = tid & 63, wave = tid >> 6;
    const float* MOD = (const float*)(p.ws + WS_MOD);
    if ((int)blockIdx.x < bfirst) return;
    for (int row = row_begin + ((int)blockIdx.x - bfirst) * 8 + wave; row < nrows; row += ((int)gridDim.x - bfirst) * 8) {
        const int b = row < T ? row / SEQL : 8;
        const float* mod = MOD + b * 9216;
        f32x4 v[4];
        if (RES_IN == 1) {
            const bf16_t* rin = (const bf16_t*)res_lat + (size_t)row * D;
#pragma unroll
            for (int i = 0; i < 4; ++i) { const u32x2 w = *(const u32x2*)(rin + (i * 64 + lane) * 4); v[i][0] = bflo(w.x); v[i][1] = bfhi(w.x); v[i][2] = bflo(w.y); v[i][3] = bfhi(w.y); }
        } else {
            const float* rin = row < T ? (const float*)res_lat + (size_t)row * D : res_ctx + (size_t)(row - T) * D;
#pragma unroll
            for (int i = 0; i < 4; ++i) v[i] = *(const f32x4*)(rin + (i * 64 + lane) * 4);
        }
        if (HAS_SRC) {
            f32x4 hsrc[4]; float ss = 0.f;
#pragma unroll
            for (int i = 0; i < 4; ++i) {
                const u32x2 w = *(const u32x2*)(SRC + (size_t)row * D + (i * 64 + lane) * 4);
                hsrc[i][0] = bflo(w.x); hsrc[i][1] = bfhi(w.x); hsrc[i][2] = bflo(w.y); hsrc[i][3] = bfhi(w.y);
                ss += hsrc[i][0] * hsrc[i][0] + hsrc[i][1] * hsrc[i][1] + hsrc[i][2] * hsrc[i][2] + hsrc[i][3] * hsrc[i][3];
            }
            ss = wave_sum(ss, lane);
            const float rstd = rsqrtf(ss * (1.0f / D) + EPS);
#pragma unroll
            for (int i = 0; i < 4; ++i) {
                const int col = (i * 64 + lane) * 4;
                const f32x4 gp = *(const f32x4*)(g_post + col), gt = *(const f32x4*)(mod + gate_idx * 1024 + col);
                v[i] += gmul * gt * (hsrc[i] * rstd * gp);
            }
        }
        if (RES_OUT == 1 && row < T) {
#pragma unroll
            for (int i = 0; i < 4; ++i) *(f32x4*)((float*)RES_OUT_P + (size_t)row * D + (i * 64 + lane) * 4) = v[i];
        }
        if (RES_OUT == 2 && row < T) {
#pragma unroll
            for (int i = 0; i < 4; ++i) { u32x2 w; w.x = pk(v[i][0], v[i][1]); w.y = pk(v[i][2], v[i][3]); *(u32x2*)((bf16_t*)RES_OUT_P + (size_t)row * D + (i * 64 + lane) * 4) = w; }
        }
        if (WRITE_XN) {
            float ss = 0.f;
#pragma unroll
            for (int i = 0; i < 4; ++i) ss += v[i][0] * v[i][0] + v[i][1] * v[i][1] + v[i][2] * v[i][2] + v[i][3] * v[i][3];
            ss = wave_sum(ss, lane);
            const float rstd = rsqrtf(ss * (1.0f / D) + EPS);
#pragma unroll
            for (int i = 0; i < 4; ++i) {
                const int col = (i * 64 + lane) * 4;
                const f32x4 gp = *(const f32x4*)(g_pre + col), sh = *(const f32x4*)(mod + shift_idx * 1024 + col), sc = *(const f32x4*)(mod + scale_idx * 1024 + col);
                const f32x4 y = (v[i] * rstd * gp) * (1.0f + sc) + sh;
                u32x2 w; w.x = pk(y[0], y[1]); w.y = pk(y[2], y[3]);
                *(u32x2*)(XN + (size_t)row * D + col) = w;
            }
        }
    }
}
DI void conv8(const bf16_t* prow, int t0, float w0, float w1, float w2, float bias, float (&out)[8]) {
    const u32x4 a = *(const u32x4*)(prow + t0);
    float x[10];
    x[0] = t0 > 0 ? bf2f(prow[t0 - 1]) : 0.f; x[9] = t0 + 8 < SEQL ? bf2f(prow[t0 + 8]) : 0.f;
    x[1] = bflo(a.x); x[2] = bfhi(a.x); x[3] = bflo(a.y); x[4] = bfhi(a.y); x[5] = bflo(a.z); x[6] = bfhi(a.z); x[7] = bflo(a.w); x[8] = bfhi(a.w);
#pragma unroll
    for (int j = 0; j < 8; ++j) out[j] = w0 * x[j] + w1 * x[j + 1] + w2 * x[j + 2] + bias;
}
__device__ __forceinline__ void hyena_phase(const Params& p, LAS unsigned char* lds) {
    const int tid = tid_opaque(), lane = tid & 63, wave = __builtin_amdgcn_readfirstlane(tid >> 6), r = lane & 31, h = lane >> 5;
    const bf16_t* ZT = (const bf16_t*)(p.ws + WS_ZT); const unsigned short* GIMG = (const unsigned short*)(p.ws + WS_GIMG); bf16_t* HYT = (bf16_t*)(p.ws + WS_HYT);
    const float* cw = p.in[10]; const float* cb = p.in[11]; const float* hyb = p.in[20];
    constexpr int UROW = 8768, IOFF = 70144, ZOFF = 103424;
    if (tid < 32) *(LAS u32x4*)(lds + ZOFF + tid * 16) = (u32x4){0u, 0u, 0u, 0u};
    const int cb_ = r >> 2, ctb = 4 * wave + (r & 3);
    const int dlo = (4 * wave - 31) > -31 ? (4 * wave - 31) : -31, dhi = (4 * wave + 3) < 31 ? (4 * wave + 3) : 31;
    for (int c = blockIdx.x; c < 1024; c += gridDim.x) {
        { const u32x4* src = (const u32x4*)(GIMG + (size_t)c * IMGN); for (int i = tid; i < IMGN / 8; i += 512) *(LAS u32x4*)(lds + IOFF + i * 16) = src[i]; }
        {
            const float wx0 = cw[1024 + c], wx1 = cw[3072 + 1024 + c], wx2 = cw[6144 + 1024 + c], bx = cb[1024 + c];
            const float wv0 = cw[2048 + c], wv1 = cw[3072 + 2048 + c], wv2 = cw[6144 + 2048 + c], bv = cb[2048 + c];
#pragma unroll 2
            for (int it = 0; it < 8; ++it) {
                const int idx8 = it * 512 + tid, b = idx8 >> 9, t0 = (idx8 & 511) * 8;
                float x1c[8], vc[8];
                conv8(ZT + (size_t)(1024 + c) * T + b * SEQL, t0, wx0, wx1, wx2, bx, x1c);
                conv8(ZT + (size_t)(2048 + c) * T + b * SEQL, t0, wv0, wv1, wv2, bv, vc);
                u32x4 w; w.x = pk(vc[0] * x1c[0], vc[1] * x1c[1]); w.y = pk(vc[2] * x1c[2], vc[3] * x1c[3]); w.z = pk(vc[4] * x1c[4], vc[5] * x1c[5]); w.w = pk(vc[6] * x1c[6], vc[7] * x1c[7]);
                *(LAS u32x4*)(lds + b * UROW + (t0 >> 7) * 272 + (t0 & 127) * 2) = w;
            }
        }
        __syncthreads();
        f32x16 acc[4];
#pragma unroll
        for (int mi = 0; mi < 4; ++mi)
#pragma unroll
            for (int i = 0; i < 16; ++i) acc[mi][i] = 0.f;
        const LAS unsigned* img32 = (const LAS unsigned*)(lds + IOFF);
        const int wl = ((r & 1) ? (OFFO / 2) : 0) + ((SEQL - r + 8 * h - (r & 1)) >> 1);
        bf16x8 A[14], Bc[8];
        {
            const LAS unsigned* ab = img32 + (wl - 64 * dlo);
#pragma unroll
            for (int o = 0; o < 14; ++o) { const LAS unsigned* q = ab - 8 * (o - 7); u32x4 w; w.x = q[0]; w.y = q[1]; w.z = q[2]; w.w = q[3]; A[o] = __builtin_bit_cast(bf16x8, w); }
            const int sb = ctb - dlo; const bool valid = (unsigned)sb < 32u;
            const LAS unsigned char* ub = lds + (valid ? cb_ * UROW + sb * 272 : ZOFF) + h * 16;
#pragma unroll
            for (int ks = 0; ks < 8; ++ks) Bc[ks] = *(const LAS bf16x8*)(ub + ks * 32);
        }
#pragma unroll 1
        for (int db = dlo; db <= dhi; ++db) {
            bf16x8 An[8], Bn[8];
            {
                const int dn = db < dhi ? db + 1 : dhi;
                const LAS unsigned* ab = img32 + (wl - 64 * dn);
#pragma unroll
                for (int j = 0; j < 8; ++j) { const LAS unsigned* q = ab - 8 * (j - 1); u32x4 w; w.x = q[0]; w.y = q[1]; w.z = q[2]; w.w = q[3]; An[j] = __builtin_bit_cast(bf16x8, w); }
                const int sb = ctb - dn; const bool valid = (unsigned)sb < 32u;
                const LAS unsigned char* ub = lds + (valid ? cb_ * UROW + sb * 272 : ZOFF) + h * 16;
#pragma unroll
                for (int ks = 0; ks < 8; ++ks) Bn[ks] = *(const LAS bf16x8*)(ub + ks * 32);
            }
            __builtin_amdgcn_sched_barrier(0);
#pragma unroll
            for (int ks = 0; ks < 8; ++ks)
#pragma unroll
                for (int mi = 0; mi < 4; ++mi) acc[mi] = MFMA32(A[2 * mi - ks + 7], Bc[ks], acc[mi]);
            __builtin_amdgcn_sched_barrier(0);
#pragma unroll
            for (int o = 0; o < 6; ++o) A[o] = A[o + 8];
#pragma unroll
            for (int j = 0; j < 8; ++j) { A[6 + j] = An[j]; Bc[j] = Bn[j]; }
        }
        __syncthreads();
        {
            const float hb = hyb[c];
#pragma unroll
            for (int mi = 0; mi < 4; ++mi)
#pragma unroll
                for (int g4 = 0; g4 < 4; ++g4) {
                    const int i0 = 32 * mi + 8 * g4 + 4 * h;
                    LAS unsigned* up = (LAS unsigned*)(lds + cb_ * UROW + ctb * 272 + i0 * 2);
                    const unsigned w0 = up[0], w1 = up[1];
                    const float y0 = acc[mi][4 * g4 + 0] + bflo(w0) * hb, y1 = acc[mi][4 * g4 + 1] + bfhi(w0) * hb, y2 = acc[mi][4 * g4 + 2] + bflo(w1) * hb, y3 = acc[mi][4 * g4 + 3] + bfhi(w1) * hb;
                    up[0] = pk(y0, y1); up[1] = pk(y2, y3);
                }
        }
        __syncthreads();
        {
            const float w0 = cw[c], w1 = cw[3072 + c], w2 = cw[6144 + c], bb = cb[c];
#pragma unroll 2
            for (int it = 0; it < 8; ++it) {
                const int idx8 = it * 512 + tid, b = idx8 >> 9, t0 = (idx8 & 511) * 8;
                float x0c[8];
                conv8(ZT + (size_t)c * T + b * SEQL, t0, w0, w1, w2, bb, x0c);
                const u32x4 y = *(const LAS u32x4*)(lds + b * UROW + (t0 >> 7) * 272 + (t0 & 127) * 2);
                u32x4 w; w.x = pk(bflo(y.x) * x0c[0], bfhi(y.x) * x0c[1]); w.y = pk(bflo(y.y) * x0c[2], bfhi(y.y) * x0c[3]);
                w.z = pk(bflo(y.z) * x0c[4], bfhi(y.z) * x0c[5]); w.w = pk(bflo(y.w) * x0c[6], bfhi(y.w) * x0c[7]);
                *(u32x4*)(HYT + (size_t)c * T + b * SEQL + t0) = w;
            }
        }
        __syncthreads();
    }
}
__device__ __forceinline__ void transpose_phase(const Params& p, unsigned char* shm) {
    unsigned short* tile = (unsigned short*)shm;
    const bf16_t* HYT = (const bf16_t*)(p.ws + WS_HYT); bf16_t* HY = (bf16_t*)(p.ws + WS_HY);
    const int tid = tid_opaque();
    for (int ti = blockIdx.x; ti < 16 * 512; ti += gridDim.x) {
        const int ct = ti & 15, tt = ti >> 4, c0 = ct * 64, t0 = tt * 64;
        { const int cl = tid >> 3, ch = tid & 7; const u32x4 v = *(const u32x4*)(HYT + (size_t)(c0 + cl) * T + t0 + ch * 8); *(u32x4*)(tile + cl * 72 + ch * 8) = v; }
        __syncthreads();
        { const int tl = tid >> 3, cc = (tid & 7) * 8; unsigned short e[8];
#pragma unroll
          for (int j = 0; j < 8; ++j) e[j] = tile[(cc + j) * 72 + tl];
          u32x4 w; w.x = e[0] | ((unsigned)e[1] << 16); w.y = e[2] | ((unsigned)e[3] << 16); w.z = e[4] | ((unsigned)e[5] << 16); w.w = e[6] | ((unsigned)e[7] << 16);
          *(u32x4*)(HY + (size_t)(t0 + tl) * D + c0 + cc) = w; }
        __syncthreads();
    }
}
DI bf16x8 pack8(const f32x16& s, int base) {
    u32x4 w; w.x = pk(s[base + 0], s[base + 1]); w.y = pk(s[base + 2], s[base + 3]); w.z = pk(s[base + 4], s[base + 5]); w.w = pk(s[base + 6], s[base + 7]);
    return __builtin_bit_cast(bf16x8, w);
}
typedef float f32x8 __attribute__((ext_vector_type(8)));
constexpr int AT_VOFF = 16384, AT_BUFSZ = 32768, AT_OOFF = 67584, AT_NKT = LK / 64;
DI void attn_pv(const LAS unsigned char* buf, const int (&voff)[4], const bf16x8 (&pf)[4], f32x16 (&o)[4]) {
#pragma unroll
    for (int s4 = 0; s4 < 4; ++s4) {
#pragma unroll
        for (int mt = 0; mt < 4; ++mt) {
            const bf16x8 vf = *(const LAS bf16x8*)(buf + voff[s4] + mt * 4096);
            o[mt] = MFMA32(vf, pf[s4], o[mt]);
        }
    }
}
__device__ __forceinline__ void attn_phase(const Params& p, LAS unsigned char* lds, bf16_t* OUTP) {
    const int tid = tid_opaque(), lane = tid & 63, wave = __builtin_amdgcn_readfirstlane(tid >> 6), r = lane & 31, h = lane >> 5, map = wave >> 2, qw = wave & 3;
    float lam;
    { float a1 = p.in[21][lane] * p.in[22][lane], a2 = p.in[23][lane] * p.in[24][lane]; a1 = wave_sum(a1, lane); a2 = wave_sum(a2, lane); lam = expf(a1) - expf(a2) + 0.2f; }
    const bf16_t* Q = (const bf16_t*)(p.ws + WS_Q); const bf16_t* K = (const bf16_t*)(p.ws + WS_K); const bf16_t* VT = (const bf16_t*)(p.ws + WS_VT);
    const float* subg = p.in[25];
    const int G = gridDim.x, bx = blockIdx.x;
    const int vcu = (G % 8 == 0) ? (bx % 8) * (G / 8) + bx / 8 : bx;
    int koff[4], voff[4];
#pragma unroll
    for (int ks = 0; ks < 4; ++ks) koff[ks] = r * 256 + ((((map * 8 + 2 * ks + h) ^ (r & 15))) << 4);
#pragma unroll
    for (int s4 = 0; s4 < 4; ++s4) voff[s4] = AT_VOFF + r * 128 + ((((2 * s4 + h) ^ ((r >> 1) & 7))) << 4);
    int ksrc[2], vsrc[2];
#pragma unroll
    for (int i = 0; i < 2; ++i) {
        const int j = 2 * wave + i;
        const int krow = 4 * j + (lane >> 4), kc = (lane & 15) ^ (krow & 15);
        ksrc[i] = krow * D + kc * 8;
        const int ve = 8 * j + (lane >> 3), vc = (lane & 7) ^ ((ve >> 1) & 7);
        vsrc[i] = ve * LK + vc * 8;
    }
    for (int i = tid; i < 16384 / 16; i += 512) *(LAS u32x4*)(lds + 2 * AT_BUFSZ + AT_VOFF + i * 16) = (u32x4){0u, 0u, 0u, 0u};
    __syncthreads();
#define AT_DMA(slot, kt_) do { \
        LAS unsigned char* _d = lds + (slot) * AT_BUFSZ + wave * 2048; \
        const bf16_t* _k = kg + (size_t)(kt_) * 64 * D; const bf16_t* _v = vg + (kt_) * 64; \
        __builtin_amdgcn_global_load_lds((const unsigned*)(_k + ksrc[0]), (LAS unsigned*)(_d), 16, 0, 0); \
        __builtin_amdgcn_global_load_lds((const unsigned*)(_k + ksrc[1]), (LAS unsigned*)(_d + 1024), 16, 0, 0); \
        __builtin_amdgcn_global_load_lds((const unsigned*)(_v + vsrc[0]), (LAS unsigned*)(_d + AT_VOFF), 16, 0, 0); \
        __builtin_amdgcn_global_load_lds((const unsigned*)(_v + vsrc[1]), (LAS unsigned*)(_d + AT_VOFF + 1024), 16, 0, 0); } while (0)
    for (int u = vcu; u < 2048; u += G) {
        const int b = u >> 8, hd = (u >> 5) & 7, qb = u & 31;
        const bf16_t* qp = Q + ((size_t)(b * SEQL + qb * 128 + qw * 32 + r)) * D + hd * 128 + map * 64 + 8 * h;
        bf16x8 qf[4];
#pragma unroll
        for (int ks = 0; ks < 4; ++ks) qf[ks] = *(const bf16x8*)(qp + 16 * ks);
        const bf16_t* kg = K + (size_t)b * LK * D + hd * 128;
        const bf16_t* vg = VT + ((size_t)b * D + hd * 128) * LK;
        AT_DMA(0, 0);
        asm volatile("s_waitcnt vmcnt(0)" ::: "memory");
        __syncthreads();
        float l_run = 0.f;
        f32x16 o[4], negm;
#pragma unroll
        for (int i = 0; i < 16; ++i) negm[i] = 0.f;
#pragma unroll
        for (int mt = 0; mt < 4; ++mt)
#pragma unroll
            for (int i = 0; i < 16; ++i) o[mt][i] = 0.f;
        bf16x8 pf[4];
#pragma unroll
        for (int i = 0; i < 4; ++i) pf[i] = (bf16x8){0, 0, 0, 0, 0, 0, 0, 0};
        int bcur = 0, bprev = 2;
        for (int kt = 0; kt < AT_NKT; ++kt) {
            const LAS unsigned char* cur = lds + bcur * AT_BUFSZ;
            const int bnext = (bcur == 2) ? 0 : bcur + 1;
            const bool more = kt + 1 < AT_NKT;
            if (more) AT_DMA(bnext, kt + 1);
            f32x16 s0 = negm, s1 = negm;
#pragma unroll
            for (int ks = 0; ks < 4; ++ks) {
                const bf16x8 kf0 = *(const LAS bf16x8*)(cur + koff[ks]);
                const bf16x8 kf1 = *(const LAS bf16x8*)(cur + koff[ks] + 8192);
                s0 = MFMA32(kf0, qf[ks], s0); s1 = MFMA32(kf1, qf[ks], s1);
            }
            __builtin_amdgcn_sched_barrier(0);
            float mx = fmaxf(fmaxf(s0[0], s0[1]), s0[2]);
#pragma unroll
            for (int i = 3; i < 15; i += 2) mx = fmaxf(fmaxf(mx, s0[i]), s0[i + 1]);
            mx = fmaxf(fmaxf(mx, s0[15]), s1[0]);
#pragma unroll
            for (int i = 1; i < 15; i += 2) mx = fmaxf(fmaxf(mx, s1[i]), s1[i + 1]);
            mx = fmaxf(mx, s1[15]);
            const bool need = (kt == 0) || (__builtin_amdgcn_ballot_w64(mx > 8.0f) != 0ull);
            float alpha = 1.0f;
            if (need) {
                const float mxp = fmaxf(mx, shx(mx, lane, 32));
                const float delta = (kt == 0) ? mxp : fmaxf(mxp, 0.f);
                alpha = fast_exp2(-delta);
                s0 = s0 - delta; s1 = s1 - delta; negm = negm - delta;
                l_run *= alpha;
            }
            __builtin_amdgcn_sched_barrier(0);
            attn_pv(lds + bprev * AT_BUFSZ, voff, pf, o);
#pragma unroll
            for (int i = 0; i < 16; ++i) { s0[i] = fast_exp2(s0[i]); s1[i] = fast_exp2(s1[i]); }
            {
                const f32x16 t16 = s0 + s1; const f32x8 t8 = t16.lo + t16.hi; const f32x4 t4 = t8.lo + t8.hi;
                l_run += (t4[0] + t4[1]) + (t4[2] + t4[3]);
            }
            bf16x8 pn[4];
            pn[0] = pack8(s0, 0); pn[1] = pack8(s0, 8); pn[2] = pack8(s1, 0); pn[3] = pack8(s1, 8);
#pragma unroll
            for (int i = 0; i < 16; ++i) { __builtin_amdgcn_sched_group_barrier(0x008, 1, 0); __builtin_amdgcn_sched_group_barrier(0x100, 1, 0); __builtin_amdgcn_sched_group_barrier(0x002, 5, 0); }
            __builtin_amdgcn_sched_barrier(0);
            if (need) {
#pragma unroll
                for (int mt = 0; mt < 4; ++mt) o[mt] *= alpha;
            }
#pragma unroll
            for (int i = 0; i < 4; ++i) pf[i] = pn[i];
            asm volatile("s_waitcnt vmcnt(0)" ::: "memory");
            __syncthreads();
            bprev = bcur; bcur = bnext;
        }
        attn_pv(lds + bprev * AT_BUFSZ, voff, pf, o);
        __syncthreads();
        const float ltot = l_run + shx(l_run, lane, 32);
        const float invl = 1.0f / ltot;
        const int ql = qw * 32 + r;
        if (map == 1) {
            const float sc = invl * lam;
#pragma unroll
            for (int mt = 0; mt < 4; ++mt)
#pragma unroll
                for (int g4 = 0; g4 < 4; ++g4) {
                    const int e0 = 32 * mt + 8 * g4 + 4 * h;
                    f32x4 w; w[0] = o[mt][4 * g4] * sc; w[1] = o[mt][4 * g4 + 1] * sc; w[2] = o[mt][4 * g4 + 2] * sc; w[3] = o[mt][4 * g4 + 3] * sc;
                    *(LAS f32x4*)(lds + (ql * 132 + e0) * 4) = w;
                }
        }
        __syncthreads();
        if (map == 0) {
            float ss = 0.f;
#pragma unroll
            for (int mt = 0; mt < 4; ++mt)
#pragma unroll
                for (int g4 = 0; g4 < 4; ++g4) {
                    const int e0 = 32 * mt + 8 * g4 + 4 * h;
                    const f32x4 w = *(const LAS f32x4*)(lds + (ql * 132 + e0) * 4);
#pragma unroll
                    for (int j = 0; j < 4; ++j) { const float v = o[mt][4 * g4 + j] * invl - w[j]; o[mt][4 * g4 + j] = v; ss += v * v; }
                }
            ss += shx(ss, lane, 32);
            const float rstd = rsqrtf(ss * (1.0f / 128.0f) + EPS) * 0.8f;
#pragma unroll
            for (int mt = 0; mt < 4; ++mt)
#pragma unroll
                for (int g4 = 0; g4 < 4; ++g4) {
                    const int e0 = 32 * mt + 8 * g4 + 4 * h;
                    const f32x4 sg = *(const f32x4*)(subg + e0);
                    u32x2 w; w.x = pk(o[mt][4 * g4] * rstd * sg[0], o[mt][4 * g4 + 1] * rstd * sg[1]); w.y = pk(o[mt][4 * g4 + 2] * rstd * sg[2], o[mt][4 * g4 + 3] * rstd * sg[3]);
                    *(LAS u32x2*)(lds + AT_OOFF + ql * 272 + e0 * 2) = w;
                }
        }
        __syncthreads();
#pragma unroll
        for (int i = 0; i < 4; ++i) {
            const int cid = tid + 512 * i, row = cid >> 4, ch = cid & 15;
            const u32x4 w = *(const LAS u32x4*)(lds + AT_OOFF + row * 272 + ch * 16);
            *(u32x4*)(OUTP + ((size_t)(b * SEQL + qb * 128 + row)) * D + hd * 128 + ch * 8) = w;
        }
        __syncthreads();
    }
#undef AT_DMA
}

#define XB_TMO      128
#define XB_XCNT(j)  (256  + 64 * (j))
#define XB_XSUB(j)  (1280 + 64 * (j))
#define XB_XGEN(j)  (2304 + 64 * (j))
#define XB_TOP      3328
#define XB_TOPGEN   3392
#define XCD_BAR_WORDS 3456
#define XB_SPIN_CAP (1u << 18)

__device__ __forceinline__ unsigned xb_ld(unsigned* p)              { return __hip_atomic_load(p, __ATOMIC_RELAXED, __HIP_MEMORY_SCOPE_AGENT); }
__device__ __forceinline__ unsigned xb_add(unsigned* p, unsigned v) { return __hip_atomic_fetch_add(p, v, __ATOMIC_RELAXED, __HIP_MEMORY_SCOPE_AGENT); }
__device__ __forceinline__ unsigned xb_xcc_id() { return (unsigned)__builtin_amdgcn_s_getreg((3 << 11) | 20) & 0xFu; }
#define XB_SPIN(cond, bar) do { unsigned _sp = 0; while (cond) { __builtin_amdgcn_s_sleep(1); \
    if ((++_sp & 255u) == 0u) { if (xb_ld(&(bar)[XB_TMO])) break; if (_sp > XB_SPIN_CAP) { atomicAdd(&(bar)[XB_TMO], 1u); break; } } } } while (0)

struct XcdBarrier {
    unsigned* bar; unsigned x;
    volatile LAS unsigned* st;
};

__device__ __forceinline__ XcdBarrier xcd_barrier_post(unsigned* bar, volatile LAS unsigned* st) {
    XcdBarrier b; b.bar = bar; b.x = xb_xcc_id(); b.st = st;
    if (threadIdx.x == 0) (void)xb_add(&bar[XB_XCNT(b.x)], 1u);
    return b;
}
__device__ __forceinline__ void xcd_barrier_complete(unsigned* bar, unsigned x, unsigned& nloc, unsigned& nx) {
    const unsigned G = gridDim.x * gridDim.y * gridDim.z;
    unsigned sum, cnt, mine, sp = 0u;
    for (;;) {
        sum = 0u; cnt = 0u; mine = 0u;
#pragma unroll
        for (unsigned j = 0; j < 16; ++j) { const unsigned c = xb_ld(&bar[XB_XCNT(j)]); sum += c; cnt += (c > 0u) ? 1u : 0u; mine = (j == x) ? c : mine; }
        if (sum == G) break;
        __builtin_amdgcn_s_sleep(1);
        if ((++sp & 255u) == 0u) { if (xb_ld(&bar[XB_TMO])) break; if (sp > XB_SPIN_CAP) { atomicAdd(&bar[XB_TMO], 1u); break; } }
    }
    nloc = mine > 0u ? mine : 1u; nx = cnt > 0u ? cnt : 1u;
}

__device__ __forceinline__ void xcd_barrier(const XcdBarrier& b) {
    asm volatile("s_waitcnt vmcnt(0)" ::: "memory");
    __syncthreads();
    if (threadIdx.x == 0) {
        unsigned* bar = b.bar;
        __builtin_amdgcn_s_waitcnt(0);
        unsigned nloc = b.st[0], nx = b.st[1];
        if (nloc == 0u) { xcd_barrier_complete(bar, b.x, nloc, nx); b.st[0] = nloc; b.st[1] = nx; }
        const unsigned old = xb_add(&bar[XB_XSUB(b.x)], 1u);
        const unsigned gen = old / nloc;
        if (old + 1u == (gen + 1u) * nloc) {
            __builtin_amdgcn_fence(__ATOMIC_RELEASE, "agent");
            asm volatile("s_waitcnt vmcnt(0)" ::: "memory");
            const unsigned og = xb_add(&bar[XB_TOP], 1u);
            const unsigned tg = og / nx;
            if (og + 1u == (tg + 1u) * nx) xb_add(&bar[XB_TOPGEN], 1u);
            else XB_SPIN(xb_ld(&bar[XB_TOPGEN]) == tg, bar);
            __builtin_amdgcn_fence(__ATOMIC_ACQUIRE, "agent");
            xb_add(&bar[XB_XGEN(b.x)], 1u);
            asm volatile("s_waitcnt vmcnt(0)" ::: "memory");
        } else {
            XB_SPIN(xb_ld(&bar[XB_XGEN(b.x)]) == gen, bar);
            __builtin_amdgcn_fence(__ATOMIC_ACQUIRE, "agent");
            asm volatile("s_waitcnt vmcnt(0)" ::: "memory");
        }
    }
    __syncthreads();
}

__global__ void __launch_bounds__(512, 2) mega_fwd(Params p) {
    extern __shared__ __attribute__((aligned(16))) unsigned char shm[];
    cg::grid_group grid = cg::this_grid();
    LAS unsigned char* lds = (LAS unsigned char*)shm;
    unsigned char* ws = p.ws;
    volatile LAS unsigned* xbst = (volatile LAS unsigned*)(lds + 131072 + 4080);
    if (threadIdx.x < 4) xbst[threadIdx.x] = 0u;
    __syncthreads();
    const XcdBarrier xbar = xcd_barrier_post((unsigned*)(ws + WS_BAR), xbst);
    const float* x = p.in[0]; const float* ctx = p.in[2]; const float* ng = p.in[6];
    bf16_t* XN = (bf16_t*)(ws + WS_XN); bf16_t* ACT = (bf16_t*)(ws + WS_ACT); bf16_t* H = (bf16_t*)(ws + WS_H);
    bf16_t* ZT = (bf16_t*)(ws + WS_ZT); bf16_t* Qb = (bf16_t*)(ws + WS_Q); bf16_t* Kb = (bf16_t*)(ws + WS_K); bf16_t* VTb = (bf16_t*)(ws + WS_VT);
    bf16_t* HY = (bf16_t*)(ws + WS_HY); bf16_t* BUFG = (bf16_t*)(ws + WS_BUFG); bf16_t* MERGED = (bf16_t*)(ws + WS_MERGED); bf16_t* Y = (bf16_t*)(ws + WS_Y);
    const bf16_t* WA = (const bf16_t*)(ws + WS_WA); const bf16_t* WB = (const bf16_t*)(ws + WS_WB); const bf16_t* WG = (const bf16_t*)(ws + WS_WG);
    const float* ROPE = (const float*)(ws + WS_ROPE);

    p0_adaln(p, shm);
    p0_h3(p);
    {
        const int bx = (int)blockIdx.x, G = (int)gridDim.x;
        if (G == 256) { if (bx < 144) convert_tiles(p, shm, bx, 144, 2160, 0); else convert_tiles(p, shm, 2160 + bx - 144, 112, 4672, 0); }
        else convert_tiles(p, shm, bx, G, 4672, 0);
    }
    if (p.out == nullptr) grid.sync();
    xcd_barrier(xbar);
    row_phase<false, 0, 0, true>(p, nullptr, x, ctx, nullptr, XN, TT, nullptr, 0.f, 0, ng + 0 * D, 0, 1);
    p1_filter(p, shm);
    xcd_barrier(xbar);
    { EpiSwiGLU E{ACT}; run_gemm(lds, XN, (const bf16_t*)(ws + WS_WFF_IN0), TT, 2 * FF, D, E); }
    {
        const int bx = (int)blockIdx.x, G = (int)gridDim.x;
        if (G == 256) { if (bx >= 176) convert_tiles(p, shm, bx - 176, 80, 960, 2); }
        else convert_tiles(p, shm, bx, G, 960, 2);
    }
    xcd_barrier(xbar);
    { auto E = mk_epi<0>(H, D); run_gemm(lds, ACT, (const bf16_t*)(ws + WS_WFF_OUT0), T, D, FF, E); }
    xcd_barrier(xbar);
    { auto E = mk_epi<0>(H + (size_t)T * D, D); run_gemm(lds, ACT + (size_t)T * FF, (const bf16_t*)(ws + WS_WFF_OUT0), TC, D, FF, E, 0, 32); }
    row_phase<true, 0, 2, true>(p, H, x, ctx, p.out, XN, T, ng + 1 * D, 0.5f, 2, ng + 2 * D, 3, 4, 0, (int)gridDim.x > 64 ? 32 : 0);
    xcd_barrier(xbar);
    row_phase<true, 0, 0, true>(p, H, x, ctx, nullptr, XN, TT, ng + 1 * D, 0.5f, 2, ng + 2 * D, 3, 4, T, 0);
    { auto E = mk_epi<0>(ZT, T); run_gemm(lds, WA, XN, 3072, T, D, E); }
    xcd_barrier(xbar);
    hyena_phase(p, lds);
    xcd_barrier(xbar);
    { auto E = mk_epi<5>(VTb, LK); E.ctpb = 16; E.cbstride = (long)D * LK; run_gemm(lds, WA + (size_t)3072 * D, XN, 1024, T, D, E); }
    { auto E = mk_epi<5>(VTb, LK); E.ctpb = 1; E.cbstride = (long)D * LK; E.coloff = SEQL; run_gemm(lds, WA + (size_t)3072 * D, XN + (size_t)T * D, 1024, TC, D, E, 64); }
    { EpiQK E; E.q = mk_epi<1>(Qb, D); E.q.rope = ROPE; E.q.scale = 0.125f * 1.4426950408889634f;
      E.k = mk_epi<1>(Kb, D); E.k.rope = ROPE; E.k.scale = 1.0f; E.k.rtpb = 16; E.k.rbstride = LK;
      run_gemm(lds, XN, WB, T, 2048, D, E); }
    { auto E = mk_epi<0>(Kb, D); E.rtpb = 1; E.rbstride = LK; E.rowoff = SEQL; run_gemm(lds, XN + (size_t)T * D, WB + (size_t)1024 * D, TC, 1024, D, E, 128); }
    {
        const int bx = (int)blockIdx.x, G = (int)gridDim.x;
        if (G == 256) { if (!((bx >= 64 && bx < 96) || (bx >= 128 && bx < 160))) { const int idx = bx < 64 ? bx : (bx < 128 ? bx - 32 : bx - 64); convert_tiles(p, shm, idx, 192, 1408, 1); } }
        else convert_tiles(p, shm, bx, G, 1408, 1);
    }
    xcd_barrier(xbar);
    attn_phase(p, lds, Qb);
    transpose_phase(p, shm);
    xcd_barrier(xbar);
    { auto E = mk_epi<2>(BUFG, 2 * D); run_gemm(lds, XN, WG, T, 2048, D, E); }
    { auto E = mk_epi<3>(MERGED, D, BUFG); E.ldg = 2 * D; run_gemm(lds, HY, (const bf16_t*)(ws + WS_WHY), T, 1024, D, E); }
    { auto E = mk_epi<4>(MERGED, D, BUFG + D); E.ldg = 2 * D; run_gemm(lds, Qb, (const bf16_t*)(ws + WS_WDA), T, 1024, D, E); }
    xcd_barrier(xbar);
    { auto E = mk_epi<0>(Y, D); run_gemm(lds, MERGED, (const bf16_t*)(ws + WS_WO), T, 1024, D, E); }
    xcd_barrier(xbar);
    row_phase<true, 1, 2, true>(p, Y, p.out, nullptr, ws + WS_MERGED, XN, T, ng + 3 * D, 1.0f, 5, ng + 4 * D, 6, 7);
    xcd_barrier(xbar);
    { EpiSwiGLU E{ACT}; run_gemm(lds, XN, (const bf16_t*)(ws + WS_WFF_IN1), T, 2 * FF, D, E); }
    xcd_barrier(xbar);
    { auto E = mk_epi<0>(H, D); run_gemm(lds, ACT, (const bf16_t*)(ws + WS_WFF_OUT1), T, D, FF, E); }
    xcd_barrier(xbar);
    row_phase<true, 1, 1, false>(p, H, ws + WS_MERGED, nullptr, p.out, nullptr, T, ng + 5 * D, 0.5f, 8, nullptr, 0, 0);
}

extern "C" void kernel_launch(void* const* d_in, const int* in_sizes, int n_in, void* d_out, int out_size, void* d_ws, size_t ws_size, hipStream_t stream) {
    static int grid_blocks = 0;
    if (!grid_blocks) {
        if (n_in != 29 || ws_size < WS_END) { fprintf(stderr, "kernel_launch: unexpected inputs (n_in %d, ws %zu)\n", n_in, ws_size); grid_blocks = -1; return; }
        int dev = 0, cus = 0, per_cu = 0;
        hipGetDevice(&dev);
        hipDeviceGetAttribute(&cus, hipDeviceAttributeMultiprocessorCount, dev);
        if (hipFuncSetAttribute((const void*)mega_fwd, hipFuncAttributeMaxDynamicSharedMemorySize, LDS_BYTES) != hipSuccess) { fprintf(stderr, "kernel_launch: hipFuncSetAttribute failed\n"); grid_blocks = -1; return; }
        hipOccupancyMaxActiveBlocksPerMultiprocessor(&per_cu, (const void*)mega_fwd, 512, LDS_BYTES);
        if (per_cu < 1) { fprintf(stderr, "kernel_launch: occupancy query returned %d\n", per_cu); per_cu = 1; }
        grid_blocks = cus * per_cu;
    }
    if (grid_blocks < 0) return;
    Params p{};
    for (int i = 0; i < 29; ++i) p.in[i] = (const float*)d_in[i];
    p.out = (float*)d_out; p.ws = (unsigned char*)d_ws;
    if (hipMemsetAsync((char*)d_ws + WS_BAR, 0, XCD_BAR_WORDS * 4, stream) != hipSuccess) { fprintf(stderr, "kernel_launch: memset of the barrier words failed\n"); return; }
    void* args[] = {&p};
    hipError_t e = hipLaunchCooperativeKernel((const void*)mega_fwd, dim3(grid_blocks), dim3(512), args, LDS_BYTES, stream);
    if (e != hipSuccess) fprintf(stderr, "kernel_launch: cooperative launch failed: %s (grid %d)\n", hipGetErrorString(e), grid_blocks);
}
```
